# Optimizing an MI355X kernel written in HIP

```python
import jax, jax.numpy as jnp
from jax import lax
import numpy as np

D_MODEL = 1024
BATCH = 8
SEQ = 2048
DEPTH = 1
DEC_BATCH = 8
DEC_SEQ = 32
PAST_LEN = 2048

CHUNK = 64
LEFT_CHUNKS = 8
BAND = (LEFT_CHUNKS + 1) * CHUNK
ATTN_WIDTH = D_MODEL // 2
N_HEADS = 8
HEAD_DIM = ATTN_WIDTH // N_HEADS
CONV_WIDTH = D_MODEL - ATTN_WIDTH
CONV_KERNEL = 31
REL_CLIP = 128
N_REL = 2 * REL_CLIP + 1
D_FF = -(-8 * D_MODEL // (3 * 256)) * 256
D_IN = 3 * ATTN_WIDTH + 2 * CONV_WIDTH
RMS_EPS = 1e-6
LN_EPS = 1e-5
NEG_INF = -1e30

kernel_name = "hymba_style_streaming_conformer_step"


def rmsnorm(x, g):
    xf = x.astype(jnp.float32)
    y = xf * lax.rsqrt(jnp.mean(xf * xf, axis=-1, keepdims=True) + RMS_EPS)
    return (y * g.astype(jnp.float32)).astype(x.dtype)


def layernorm(x, g, b):
    xf = x.astype(jnp.float32)
    mu = jnp.mean(xf, axis=-1, keepdims=True)
    xc = xf - mu
    y = xc * lax.rsqrt(jnp.mean(xc * xc, axis=-1, keepdims=True) + LN_EPS)
    return (y * g.astype(jnp.float32) + b.astype(jnp.float32)).astype(x.dtype)


def rel_bias(table, q_idx, k_idx, offset):
    rel = q_idx[:, None] - k_idx[None, :] + offset
    return table[:, jnp.clip(rel, -REL_CLIP, REL_CLIP) + REL_CLIP]


def chunk_attend(q, k, v, bias, key_valid):
    s = jnp.einsum('bnqhd,bnkhd->bnhqk', q, k).astype(jnp.float32) * (HEAD_DIM ** -0.5)
    s = s + bias.astype(jnp.float32)[None, None]
    if key_valid is not None:
        s = jnp.where(key_valid[None, :, None, None, :], s, NEG_INF)
    p = jax.nn.softmax(s, axis=-1).astype(v.dtype)
    return jnp.einsum('bnhqk,bnkhd->bnqhd', p, v)


def band_attention_prompt(q, k, v, table):
    B, S, H, Dh = q.shape
    nc = S // CHUNK
    pad = LEFT_CHUNKS * CHUNK
    kp = jnp.pad(k, ((0, 0), (pad, 0), (0, 0), (0, 0)))
    vp = jnp.pad(v, ((0, 0), (pad, 0), (0, 0), (0, 0)))
    idx = (jnp.arange(nc) * CHUNK)[:, None] + jnp.arange(BAND)[None, :]
    kb = kp[:, idx]
    vb = vp[:, idx]
    bias = rel_bias(table, jnp.arange(CHUNK), jnp.arange(BAND), pad)
    key_valid = idx >= pad
    o = chunk_attend(q.reshape(B, nc, CHUNK, H, Dh), kb, vb, bias, key_valid)
    return o.reshape(B, S, H * Dh)


def band_attention_sample(q, k, v, cache_k, cache_v, table):
    B, T, H, Dh = q.shape
    W = cache_k.shape[1]
    k_all = jnp.concatenate([cache_k, k], axis=1)
    v_all = jnp.concatenate([cache_v, v], axis=1)
    bias = rel_bias(table, jnp.arange(T), jnp.arange(W + T), W)
    o = chunk_attend(q[:, None], k_all[:, None], v_all[:, None], bias, None)
    return o.reshape(B, T, H * Dh), k_all[:, -W:], v_all[:, -W:]


def conformer_conv(u_glu, conv_past, w_dw, b_dw, ln_g, ln_b):
    a, g = jnp.split(u_glu, 2, axis=-1)
    u = a * jax.nn.sigmoid(g)
    buf = jnp.concatenate([conv_past.astype(u.dtype), u], axis=1)
    y = lax.conv_general_dilated(buf, w_dw[:, None, :].astype(u.dtype), (1,), 'VALID',
                                 dimension_numbers=('NWC', 'WIO', 'NWC'),
                                 feature_group_count=CONV_WIDTH) + b_dw
    y = jax.nn.silu(layernorm(y, ln_g, ln_b))
    return y, buf[:, -(CONV_KERNEL - 1):]


def trunk_layer(x, kv_past, conv_past, g_mix, w_in, rel_table, w_dw, b_dw, ln_g, ln_b,
                w_out, g_ffn, w_gate, w_up, w_down):
    B, T, _ = x.shape
    z = rmsnorm(x, g_mix) @ w_in
    q, k, v, u = jnp.split(z, [ATTN_WIDTH, 2 * ATTN_WIDTH, 3 * ATTN_WIDTH], axis=-1)
    q = q.reshape(B, T, N_HEADS, HEAD_DIM)
    k = k.reshape(B, T, N_HEADS, HEAD_DIM)
    v = v.reshape(B, T, N_HEADS, HEAD_DIM)
    if kv_past is None:
        o_attn = band_attention_prompt(q, k, v, rel_table)
        w_keep = min(LEFT_CHUNKS * CHUNK, T)
        new_k, new_v = k[:, -w_keep:], v[:, -w_keep:]
        conv_past = jnp.zeros((B, CONV_KERNEL - 1, CONV_WIDTH), u.dtype)
    else:
        o_attn, new_k, new_v = band_attention_sample(q, k, v, kv_past[0], kv_past[1], rel_table)
    o_conv, new_conv = conformer_conv(u, conv_past, w_dw, b_dw, ln_g, ln_b)
    x = x + jnp.concatenate([o_attn, o_conv], axis=-1) @ w_out
    h = rmsnorm(x, g_ffn)
    x = x + (jax.nn.silu(h @ w_gate) * (h @ w_up)) @ w_down
    return x, new_k, new_v, new_conv


def setup_inputs(seed: int = 0) -> dict:
    key = jax.random.key(seed)
    ks = jax.random.split(key, 20)
    f32 = jnp.float32
    nrm = lambda k, shape, scale: jax.random.normal(k, shape, f32) * scale
    w_past = min(LEFT_CHUNKS * CHUNK, PAST_LEN)
    return {
        "x_prompt": nrm(ks[0], (BATCH, SEQ, D_MODEL), 1.0),
        "x_sample": nrm(ks[1], (DEC_BATCH, DEC_SEQ, D_MODEL), 1.0),
        "cache_k": nrm(ks[2], (DEPTH, DEC_BATCH, w_past, N_HEADS, HEAD_DIM), 1.0),
        "cache_v": nrm(ks[3], (DEPTH, DEC_BATCH, w_past, N_HEADS, HEAD_DIM), 1.0),
        "state_conv": nrm(ks[4], (DEPTH, DEC_BATCH, CONV_KERNEL - 1, CONV_WIDTH), 1.0),
        "g_mix": 1.0 + nrm(ks[5], (DEPTH, D_MODEL), 0.02),
        "w_in": nrm(ks[6], (DEPTH, D_MODEL, D_IN), D_MODEL ** -0.5),
        "rel_table": nrm(ks[7], (DEPTH, N_HEADS, N_REL), 0.1),
        "w_dw": nrm(ks[8], (DEPTH, CONV_KERNEL, CONV_WIDTH), CONV_KERNEL ** -0.5),
        "b_dw": nrm(ks[9], (DEPTH, CONV_WIDTH), 0.02),
        "ln_g": 1.0 + nrm(ks[10], (DEPTH, CONV_WIDTH), 0.02),
        "ln_b": nrm(ks[11], (DEPTH, CONV_WIDTH), 0.02),
        "w_out": nrm(ks[12], (DEPTH, D_MODEL, D_MODEL), D_MODEL ** -0.5),
        "g_ffn": 1.0 + nrm(ks[13], (DEPTH, D_MODEL), 0.02),
        "w_gate": nrm(ks[14], (DEPTH, D_MODEL, D_FF), D_MODEL ** -0.5),
        "w_up": nrm(ks[15], (DEPTH, D_MODEL, D_FF), D_MODEL ** -0.5),
        "w_down": nrm(ks[16], (DEPTH, D_FF, D_MODEL), D_FF ** -0.5),
        "g_final": 1.0 + nrm(ks[17], (D_MODEL,), 0.02),
    }


def reference(x_prompt, x_sample, cache_k, cache_v, state_conv, g_mix, w_in, rel_table,
              w_dw, b_dw, ln_g, ln_b, w_out, g_ffn, w_gate, w_up, w_down, g_final):
    xp, xs = x_prompt, x_sample
    kp_l, vp_l, cp_l, ks_l, vs_l, cs_l = [], [], [], [], [], []
    for l in range(DEPTH):
        params = (g_mix[l], w_in[l], rel_table[l], w_dw[l], b_dw[l], ln_g[l], ln_b[l],
                  w_out[l], g_ffn[l], w_gate[l], w_up[l], w_down[l])
        xp, kp, vp, cp = trunk_layer(xp, None, None, *params)
        xs, kn, vn, cn = trunk_layer(xs, (cache_k[l], cache_v[l]), state_conv[l], *params)
        kp_l.append(kp); vp_l.append(vp); cp_l.append(cp)
        ks_l.append(kn); vs_l.append(vn); cs_l.append(cn)
    y_prompt = rmsnorm(xp, g_final)
    y_sample = rmsnorm(xs, g_final)
    return (y_prompt, y_sample, jnp.stack(kp_l), jnp.stack(vp_l), jnp.stack(cp_l),
            jnp.stack(ks_l), jnp.stack(vs_l), jnp.stack(cs_l))
```

```cpp
#include <hip/hip_runtime.h>
#include <hip/hip_cooperative_groups.h>
#include <cstdio>
#include <cstdint>
namespace cg = cooperative_groups;
namespace pg8 {
#define PG8_LAS __attribute__((address_space(3)))
typedef unsigned short bf16_t;
typedef short bf16x8 __attribute__((ext_vector_type(8)));
typedef float f32x4 __attribute__((ext_vector_type(4)));
typedef unsigned u32x4 __attribute__((ext_vector_type(4)));
constexpr int BM = 256, BK = 64, HALF = 128, HTB = HALF * BK * 2  , STAGE_BYTES = 8 * HTB, NXCD = 8, WGM = 8;

__host__ __device__ __forceinline__ int lds_byte(int r, int c) { const int st = (r >> 4) * 2 + (c >> 5), rr = r & 15, cc = c & 31, ob = rr * 64 + cc * 2; return st * 1024 + (ob ^ (((ob >> 9) & 1) << 5)); }
__host__ __device__ __forceinline__ void stage_rc(int b, int& R, int& C) { const int st = b / 1024, sb = b % 1024, swz = sb ^ (((sb >> 9) & 1) << 5); R = (st >> 1) * 16 + swz / 64; C = (st & 1) * 32 + (swz % 64) / 2; }
__host__ __device__ __forceinline__ int perm32(int rho) { const int n = rho >> 4, i = rho & 15; return 8 * (i >> 2) + 4 * n + (i & 3); }

struct Unit { int pm, pn; };
struct Gemm { const bf16_t* A; const bf16_t* Bt; int M, N, K; };

struct StaticOrder {
    int nM, nN, nwg, G, c;
    __host__ __device__ void init(int M, int N, int G_, int c_) { nM = M / BM; nN = N / BM; nwg = nM * nN; G = G_; c = c_; }
    __host__ __device__ bool next(int i, Unit& u) const {
        const long L = (long)i * G + c; if (L >= nwg) return false;
        int wgid = (int)L; { const int q = nwg / NXCD, r = nwg % NXCD, xcd = wgid % NXCD, off = wgid / NXCD; wgid = (xcd < r ? xcd * (q + 1) : r * (q + 1) + (xcd - r) * q) + off; }
        const int nig = WGM * nN, gid = wgid / nig, fm = gid * WGM, gsz = (nM - fm) < WGM ? (nM - fm) : WGM;
        u.pm = fm + ((wgid % nig) % gsz); u.pn = (wgid % nig) / gsz; return true;
    }
    __device__ __forceinline__ void a_ready(const Unit&) const {}
    __device__ __forceinline__ void done(const Unit&) const {}
};

__device__ __forceinline__ unsigned cvt_pk_bf16(float lo, float hi) { unsigned r; asm volatile("v_cvt_pk_bf16_f32 %0, %1, %2" : "=v"(r) : "v"(lo), "v"(hi)); return r; }
typedef float f32x2 __attribute__((ext_vector_type(2)));

constexpr int R_PROMPT = 16384, T_SEQ = 2048;
constexpr size_t OFF_Y = 0, OFF_KP = 17039360, OFF_VP = 19136512, OFF_CP = 21233664, OFF_KS = 21356544, OFF_VS = 23453696, OFF_CS = 25550848;

__device__ __forceinline__ u32x4 pack8(const f32x4 a, const f32x4 b) { u32x4 w; w.x = cvt_pk_bf16(a[0], a[1]); w.y = cvt_pk_bf16(a[2], a[3]); w.z = cvt_pk_bf16(b[0], b[1]); w.w = cvt_pk_bf16(b[2], b[3]); return w; }
__device__ __forceinline__ float fast_sigmoid(float g) { return __builtin_amdgcn_rcpf(1.0f + __builtin_amdgcn_exp2f(-1.4426950408889634f * g)); }

struct EpiQKV {
    static constexpr bool PERM = true, AFTER_DRAIN = false;
    const float* rstd0; bf16_t* Q; bf16_t* KP; bf16_t* KS; bf16_t* VT; bf16_t* VTS; bf16_t* U; float* out;
    __device__ __forceinline__ void operator()(const f32x4 (&acc)[2][2][4][2], const Unit& u, int wr, int wc, int fr, int fq) const {
        asm volatile("" : "+v"(fr), "+v"(fq));
        const int rbase = u.pm * BM + wr * 64 + fr;
        const bool sample = (u.pm == 64);
        const int kind = u.pn >> 1;
        const int b = sample ? 0 : (u.pm >> 3);
        if (kind == 0) {
            const int col0 = u.pn * BM + wc * 32 + 8 * fq;
#pragma unroll
            for (int ai = 0; ai < 2; ++ai)
#pragma unroll
                for (int m = 0; m < 4; ++m) { const int r = rbase + ai * HALF + m * 16; const float rs = rstd0[r];
#pragma unroll
                    for (int bj = 0; bj < 2; ++bj) *(u32x4*)(Q + (size_t)r * 512 + col0 + bj * HALF) = pack8(acc[ai][bj][m][0] * rs, acc[ai][bj][m][1] * rs); }
        } else if (kind == 1 || kind == 2) {
            const int col0 = (u.pn & 1) * BM + wc * 32 + 8 * fq;
            const bool isv = (kind == 2);
            const bool keep = sample || ((u.pm & 7) >= 6);
            float* ofp = out + (sample ? (isv ? OFF_VS : OFF_KS) : (isv ? OFF_VP : OFF_KP));
#pragma unroll
            for (int ai = 0; ai < 2; ++ai)
#pragma unroll
                for (int m = 0; m < 4; ++m) { const int r = rbase + ai * HALF + m * 16; const float rs = rstd0[r];
                    int sb, st, orow;
                    if (sample) { const int rr = r - R_PROMPT; sb = rr >> 5; st = 512 + (rr & 31); orow = sb * 512 + 480 + (rr & 31); }
                    else { sb = b; st = r - b * T_SEQ; orow = b * 512 + st - 1536; }
#pragma unroll
                    for (int bj = 0; bj < 2; ++bj) { const f32x4 v0 = acc[ai][bj][m][0] * rs, v1 = acc[ai][bj][m][1] * rs; const int c = col0 + bj * HALF;
                        if (keep) { *(f32x4*)(ofp + (size_t)orow * 512 + c) = v0; *(f32x4*)(ofp + (size_t)orow * 512 + c + 4) = v1; }
                        const u32x4 w = pack8(v0, v1);
                        if (!isv) { bf16_t* kd = sample ? KS + ((size_t)sb * 544 + st) * 512 : KP + (size_t)r * 512; *(u32x4*)(kd + c) = w; }
                        else { bf16_t* vd = sample ? VTS + ((size_t)sb * 512 + c) * 544 + st : VT + ((size_t)sb * 512 + c) * T_SEQ + st; const int vp = sample ? 544 : T_SEQ;
                            vd[0] = (bf16_t)(w.x & 0xffffu); vd[vp] = (bf16_t)(w.x >> 16); vd[2 * vp] = (bf16_t)(w.y & 0xffffu); vd[3 * vp] = (bf16_t)(w.y >> 16);
                            vd[4 * vp] = (bf16_t)(w.z & 0xffffu); vd[5 * vp] = (bf16_t)(w.z >> 16); vd[6 * vp] = (bf16_t)(w.w & 0xffffu); vd[7 * vp] = (bf16_t)(w.w >> 16); } } }
        } else {
            const int ch0 = (u.pn - 6) * HALF + wc * 32 + 8 * fq;
            const bool tail = sample || ((u.pm & 7) == 7);
#pragma unroll
            for (int ai = 0; ai < 2; ++ai)
#pragma unroll
                for (int m = 0; m < 4; ++m) { const int r = rbase + ai * HALF + m * 16; const float rs = rstd0[r];
                    f32x4 v[2];
#pragma unroll
                    for (int n = 0; n < 2; ++n) { const f32x4 a = acc[ai][0][m][n] * rs, g = acc[ai][1][m][n] * rs;
                        v[n] = (f32x4){a[0] * fast_sigmoid(g[0]), a[1] * fast_sigmoid(g[1]), a[2] * fast_sigmoid(g[2]), a[3] * fast_sigmoid(g[3])}; }
                    *(u32x4*)(U + (size_t)r * 512 + ch0) = pack8(v[0], v[1]);
                    if (tail) { int orow = -1;
                        if (sample) { const int rr = r - R_PROMPT; if ((rr & 31) >= 2) orow = (rr >> 5) * 30 + (rr & 31) - 2; }
                        else { const int st = r - b * T_SEQ; if (st >= T_SEQ - 30) orow = b * 30 + st - (T_SEQ - 30); }
                        if (orow >= 0) { float* o = out + (sample ? OFF_CS : OFF_CP) + (size_t)orow * 512 + ch0; *(f32x4*)o = v[0]; *(f32x4*)(o + 4) = v[1]; } } }
        }
    }
};

template <bool BF> struct EpiRes {
    static constexpr bool PERM = true, AFTER_DRAIN = false;
    const float* basep; const float* bases; float* outf; bf16_t* outb; float* ss;
    __device__ __forceinline__ void operator()(const f32x4 (&acc)[2][2][4][2], const Unit& u, int wr, int wc, int fr, int fq) const {
        asm volatile("" : "+v"(fr), "+v"(fq));
        const int rbase = u.pm * BM + wr * 64 + fr; const int col0 = u.pn * BM + wc * 32 + 8 * fq;
        const float* bp = (u.pm == 64) ? bases - (size_t)R_PROMPT * 1024 : basep;
#pragma unroll
        for (int ai = 0; ai < 2; ++ai)
#pragma unroll
            for (int m = 0; m < 4; ++m) { const int r = rbase + ai * HALF + m * 16; const size_t off = (size_t)r * 1024 + col0; float s = 0.f;
#pragma unroll
                for (int bj = 0; bj < 2; ++bj) { const f32x4 xa = *(const f32x4*)(bp + off + bj * HALF), xb = *(const f32x4*)(bp + off + bj * HALF + 4);
                    const f32x4 v0 = acc[ai][bj][m][0] + xa, v1 = acc[ai][bj][m][1] + xb;
                    *(f32x4*)(outf + off + bj * HALF) = v0; *(f32x4*)(outf + off + bj * HALF + 4) = v1;
                    if (BF) *(u32x4*)(outb + off + bj * HALF) = pack8(v0, v1);
                    s += (v0[0] * v0[0] + v0[1] * v0[1]) + (v0[2] * v0[2] + v0[3] * v0[3]) + (v1[0] * v1[0] + v1[1] * v1[1]) + (v1[2] * v1[2] + v1[3] * v1[3]); }
                s += __shfl_xor(s, 16); s += __shfl_xor(s, 32);
                if (fq == 0) (void)__hip_atomic_fetch_add(ss + r, s, __ATOMIC_RELAXED, __HIP_MEMORY_SCOPE_AGENT); }
    }
};

struct EpiGU {
    static constexpr bool PERM = true, AFTER_DRAIN = false;
    const float* ss1; bf16_t* HM;
    __device__ __forceinline__ void operator()(const f32x4 (&acc)[2][2][4][2], const Unit& u, int wr, int wc, int fr, int fq) const {
        asm volatile("" : "+v"(fr), "+v"(fq));
        const int rbase = u.pm * BM + wr * 64 + fr; const int ch0 = u.pn * HALF + wc * 32 + 8 * fq;
#pragma unroll
        for (int ai = 0; ai < 2; ++ai)
#pragma unroll
            for (int m = 0; m < 4; ++m) { const int r = rbase + ai * HALF + m * 16; const float rs = __builtin_amdgcn_rsqf(ss1[r] * (1.0f / 1024.0f) + 1e-6f);
                f32x4 v[2];
#pragma unroll
                for (int n = 0; n < 2; ++n) { const f32x4 g = acc[ai][0][m][n] * rs, up = acc[ai][1][m][n] * rs;
                    v[n] = (f32x4){g[0] * fast_sigmoid(g[0]) * up[0], g[1] * fast_sigmoid(g[1]) * up[1], g[2] * fast_sigmoid(g[2]) * up[2], g[3] * fast_sigmoid(g[3]) * up[3]}; }
                *(u32x4*)(HM + (size_t)r * 2816 + ch0) = pack8(v[0], v[1]); }
    }
};
template <class Epi, class Sched, bool ALIGN_EPI = false, bool SP2 = false>
__device__ __forceinline__ void gemm_phase(PG8_LAS unsigned char* lds, const Gemm g, const Sched& S, const Epi& E) {
    int tid_ = threadIdx.x; asm volatile("" : "+v"(tid_)); const int tid = tid_, wid = __builtin_amdgcn_readfirstlane(tid >> 6), lane = tid & 63, wr = wid >> 2, wc = wid & 3, fr = lane & 15, fq = lane >> 4;
    const int K = g.K, nt = K / BK;
    unsigned voffA[2], voffB[2];
#pragma unroll
    for (int i = 0; i < 2; ++i) { int R, C; stage_rc(tid * 16 + i * 8192, R, C); const int Rb = Epi::PERM ? ((R & ~31) + perm32(R & 31)) : R;
        voffA[i] = (unsigned)(R * K + C) * 2u; voffB[i] = (unsigned)(Rb * K + C) * 2u; }
    const size_t kstep = (size_t)(BK * 2);
    const size_t hstep = (size_t)HALF * K * 2;
    const size_t tstep = 2 * hstep;
    const unsigned ldsw = (unsigned)wid * 1024u;
    const int aoff = lds_byte(wr * 64 + fr, fq * 8), boff = lds_byte(wc * 32 + fr, fq * 8);
#define PG8_SA(b, h) (((b) * 2 + (h)) * HTB)
#define PG8_SB(b, h) ((4 + (b) * 2 + (h)) * HTB)
#define PG8_STAGE(bufoff, gbase, voff) do { _Pragma("unroll") for (int _i = 0; _i < 2; ++_i) \
        __builtin_amdgcn_global_load_lds((const unsigned*)((const char*)(gbase) + (voff)[_i]), (PG8_LAS unsigned*)(lds + (bufoff) + ldsw + _i * 8192), 16, 0, 0); } while (0)
#define PG8_LDA(dst, b, h) do { _Pragma("unroll") for (int m = 0; m < 4; ++m) _Pragma("unroll") for (int k = 0; k < 2; ++k) dst[m][k] = *(const PG8_LAS bf16x8*)(lds + PG8_SA(b, h) + aoff + m * 2048 + k * 1024); } while (0)
#define PG8_LDB(dst, b, h) do { _Pragma("unroll") for (int n = 0; n < 2; ++n) _Pragma("unroll") for (int k = 0; k < 2; ++k) dst[n][k] = *(const PG8_LAS bf16x8*)(lds + PG8_SB(b, h) + boff + n * 2048 + k * 1024); } while (0)
#define PG8_MMA(ai, bj, At, Bt) do { __builtin_amdgcn_s_setprio(1); _Pragma("unroll") for (int m = 0; m < 4; ++m) _Pragma("unroll") for (int n = 0; n < 2; ++n) _Pragma("unroll") for (int k = 0; k < 2; ++k) \
        acc[ai][bj][m][n] = __builtin_amdgcn_mfma_f32_16x16x32_bf16(Bt[n][k], At[m][k], acc[ai][bj][m][n], 0, 0, 0); __builtin_amdgcn_s_setprio(0); } while (0)
#define PG8_WAIT_V(n) asm volatile("s_waitcnt vmcnt(" #n ")" ::: "memory")
#define PG8_WAIT_L(n) asm volatile("s_waitcnt lgkmcnt(" #n ")" ::: "memory")
#define PG8_BAR __builtin_amdgcn_s_barrier()
#define PG8_SCHED __builtin_amdgcn_sched_barrier(0)
    Unit cur, nxt; int ui = 0;
    if (!S.next(0, cur)) return;
    f32x4 acc[2][2][4][2];
#pragma unroll
    for (int a = 0; a < 2; ++a)
#pragma unroll
        for (int b = 0; b < 2; ++b)
#pragma unroll
            for (int m = 0; m < 4; ++m)
#pragma unroll
                for (int n = 0; n < 2; ++n) acc[a][b][m][n] = (f32x4){0.f, 0.f, 0.f, 0.f};
    bf16x8 At[4][2], B0[2][2], B1[2][2];
    const char* cA = (const char*)g.A + (size_t)cur.pm * tstep; const char* cB = (const char*)g.Bt + (size_t)cur.pn * tstep;
    S.a_ready(cur);
    if constexpr (SP2) {
        PG8_STAGE(PG8_SB(0, 0), cB, voffB); PG8_STAGE(PG8_SB(0, 1), cB + hstep, voffB); PG8_STAGE(PG8_SA(0, 0), cA, voffA); PG8_STAGE(PG8_SA(0, 1), cA + hstep, voffA);
        if (wr == 1) PG8_BAR;
        PG8_WAIT_V(2); PG8_BAR;
        PG8_STAGE(PG8_SB(1, 0), cB + kstep, voffB); PG8_STAGE(PG8_SA(1, 0), cA + kstep, voffA); PG8_STAGE(PG8_SB(1, 1), cB + hstep + kstep, voffB);
        PG8_WAIT_V(6); PG8_BAR;
    } else {
        PG8_STAGE(PG8_SB(0, 0), cB, voffB); PG8_STAGE(PG8_SA(0, 0), cA, voffA); PG8_STAGE(PG8_SB(0, 1), cB + hstep, voffB); PG8_STAGE(PG8_SA(0, 1), cA + hstep, voffA);
        if (wr == 1) PG8_BAR;
        PG8_WAIT_V(4); PG8_BAR;
        PG8_STAGE(PG8_SB(1, 0), cB + kstep, voffB); PG8_STAGE(PG8_SA(1, 0), cA + kstep, voffA); PG8_STAGE(PG8_SB(1, 1), cB + hstep + kstep, voffB);
        PG8_WAIT_V(6); PG8_BAR;
    }
    for (;;) {
        const bool has_next = S.next(ui + 1, nxt);
        const char* nA = has_next ? (const char*)g.A + (size_t)nxt.pm * tstep : cA; const char* nB = has_next ? (const char*)g.Bt + (size_t)nxt.pn * tstep : cB;
        for (int t = 0; t < nt; t += 2) {
            const bool last = (t == nt - 2);
            const char* a1 = cA + (size_t)(t + 1) * kstep;
            const char* a2 = last ? nA : cA + (size_t)(t + 2) * kstep; const char* b2 = last ? nB : cB + (size_t)(t + 2) * kstep;
            const char* a3 = a2 + kstep; const char* b3 = b2 + kstep;
            if (last && has_next) S.a_ready(nxt);
            if constexpr (SP2) {
            PG8_LDB(B0, 0, 0); PG8_LDB(B1, 0, 1); PG8_SCHED; PG8_LDA(At, 0, 0); PG8_STAGE(PG8_SA(1, 1), a1 + hstep, voffA);
            PG8_WAIT_V(8); PG8_WAIT_L(0); PG8_BAR; PG8_MMA(0, 0, At, B0); PG8_MMA(0, 1, At, B1); PG8_BAR; PG8_SCHED;
            PG8_LDA(At, 0, 1); PG8_STAGE(PG8_SB(0, 0), b2, voffB); PG8_STAGE(PG8_SB(0, 1), b2 + hstep, voffB); PG8_STAGE(PG8_SA(0, 0), a2, voffA);
            PG8_WAIT_V(8); PG8_WAIT_L(0); PG8_BAR; PG8_MMA(1, 0, At, B0); PG8_MMA(1, 1, At, B1); PG8_BAR; PG8_SCHED;
            PG8_LDB(B0, 1, 0); PG8_LDB(B1, 1, 1); PG8_SCHED; PG8_LDA(At, 1, 0); PG8_STAGE(PG8_SA(0, 1), a2 + hstep, voffA);
            PG8_WAIT_V(8); PG8_WAIT_L(0); PG8_BAR; PG8_MMA(0, 0, At, B0); PG8_MMA(0, 1, At, B1); PG8_BAR; PG8_SCHED;
            PG8_LDA(At, 1, 1); PG8_STAGE(PG8_SB(1, 0), b3, voffB); PG8_STAGE(PG8_SB(1, 1), b3 + hstep, voffB); PG8_STAGE(PG8_SA(1, 0), a3, voffA);
            PG8_WAIT_V(8); PG8_WAIT_L(0); PG8_BAR; PG8_MMA(1, 0, At, B0); PG8_MMA(1, 1, At, B1); PG8_BAR; PG8_SCHED;
            } else {
            PG8_LDB(B0, 0, 0); PG8_SCHED; PG8_LDA(At, 0, 0); PG8_STAGE(PG8_SA(1, 1), a1 + hstep, voffA);
            PG8_WAIT_L(8); PG8_BAR; PG8_WAIT_L(0); PG8_MMA(0, 0, At, B0); PG8_BAR; PG8_SCHED;
            PG8_LDB(B1, 0, 1); PG8_STAGE(PG8_SB(0, 0), b2, voffB);
            PG8_BAR; PG8_WAIT_L(0); PG8_MMA(0, 1, At, B1); PG8_BAR;
            PG8_LDA(At, 0, 1); PG8_STAGE(PG8_SA(0, 0), a2, voffA);
            PG8_BAR; PG8_WAIT_L(0); PG8_MMA(1, 0, At, B0); PG8_BAR; PG8_SCHED;
            PG8_STAGE(PG8_SB(0, 1), b2 + hstep, voffB);
            PG8_WAIT_V(6); PG8_BAR; PG8_MMA(1, 1, At, B1); PG8_BAR;
            PG8_LDB(B0, 1, 0); PG8_SCHED; PG8_LDA(At, 1, 0); PG8_STAGE(PG8_SA(0, 1), a2 + hstep, voffA);
            PG8_WAIT_L(8); PG8_BAR; PG8_WAIT_L(0); PG8_MMA(0, 0, At, B0); PG8_BAR; PG8_SCHED;
            PG8_LDB(B1, 1, 1); PG8_STAGE(PG8_SB(1, 0), b3, voffB);
            PG8_BAR; PG8_WAIT_L(0); PG8_MMA(0, 1, At, B1); PG8_BAR;
            PG8_LDA(At, 1, 1); PG8_STAGE(PG8_SA(1, 0), a3, voffA);
            PG8_BAR; PG8_WAIT_L(0); PG8_MMA(1, 0, At, B0); PG8_BAR; PG8_SCHED;
            PG8_STAGE(PG8_SB(1, 1), b3 + hstep, voffB);
            PG8_WAIT_V(6); PG8_BAR; PG8_MMA(1, 1, At, B1); PG8_BAR;
            }
        }
        if constexpr (ALIGN_EPI) { if (wr == 0) PG8_BAR; }
        if constexpr (!Epi::AFTER_DRAIN) { E(acc, cur, wr, wc, fr, fq); S.done(cur); }
        if (!has_next) break;
#pragma unroll
        for (int a = 0; a < 2; ++a)
#pragma unroll
            for (int b = 0; b < 2; ++b)
#pragma unroll
                for (int m = 0; m < 4; ++m)
#pragma unroll
                    for (int n = 0; n < 2; ++n) acc[a][b][m][n] = (f32x4){0.f, 0.f, 0.f, 0.f};
        cur = nxt; cA = nA; cB = nB; ++ui;
        if constexpr (ALIGN_EPI) { if (wr == 1) PG8_BAR; }
    }
    PG8_WAIT_V(0);
    if constexpr (!ALIGN_EPI) { if (wr == 0) PG8_BAR; }
    PG8_BAR;
    if constexpr (Epi::AFTER_DRAIN) { E.fused(acc, cur, wr, wc, fr, fq, lds, wid, lane); S.done(cur); }
#undef PG8_SA
#undef PG8_SB
#undef PG8_STAGE
#undef PG8_LDA
#undef PG8_LDB
#undef PG8_MMA
#undef PG8_WAIT_V
#undef PG8_WAIT_L
#undef PG8_BAR
#undef PG8_SCHED
}
}

#define LAS __attribute__((address_space(3)))
using namespace pg8;
typedef unsigned u32x2 __attribute__((ext_vector_type(2)));
typedef float f32x16 __attribute__((ext_vector_type(16)));

constexpr int NWAVES = 8, NTHREADS = 512;
constexpr int DM = 1024, MROWS = 16640, RP = 16384, TS = 2048, DIN = 2560, DFF = 2816, NGU = 5632;
constexpr int LDS_BYTES = 139264;
constexpr float LOG2E = 1.4426950408889634f;

constexpr size_t MiB = 1u << 20;
constexpr size_t WS_STAT = 0;
constexpr size_t WS_WQKV = 1 * MiB;
constexpr size_t WS_WO = 7 * MiB;
constexpr size_t WS_WGU = 9 * MiB;
constexpr size_t WS_WD = 21 * MiB;
constexpr size_t WS_XB = 27 * MiB;
constexpr size_t WS_Q = 60 * MiB;
constexpr size_t WS_KP = 77 * MiB;
constexpr size_t WS_KS = 93 * MiB;
constexpr size_t WS_VT = 98 * MiB;
constexpr size_t WS_VTS = 114 * MiB;
constexpr size_t WS_U = 119 * MiB;
constexpr size_t WS_OC = 136 * MiB;
constexpr size_t WS_HM = 60 * MiB;
static_assert(WS_HM + (size_t)MROWS * DFF * 2 <= 169 * MiB, "ws map");

struct Args {
    const float *x_prompt, *x_sample, *cache_k, *cache_v, *state_conv, *g_mix, *w_in, *rel_table, *w_dw, *b_dw, *ln_g, *ln_b, *w_out, *g_ffn, *w_gate, *w_up, *w_down, *g_final;
    float* out; unsigned char* ws;
};

__device__ __forceinline__ unsigned cvtpk(float lo, float hi) { unsigned r; asm volatile("v_cvt_pk_bf16_f32 %0, %1, %2" : "=v"(r) : "v"(lo), "v"(hi)); return r; }
__device__ __forceinline__ float wave_sum(float v) {
#pragma unroll
    for (int o = 1; o < 64; o <<= 1) v += __shfl_xor(v, o);
    return v;
}
#define LDS_WAIT() asm volatile("s_waitcnt lgkmcnt(0)" ::: "memory")

__device__ __forceinline__ void transpose_item(const float* W, int ldw, int srccol0, int k0, bf16_t* WT, int ldt, int dstrow0, const float* gs, LAS float* scr, int lane) {
#pragma unroll 8
    for (int i = 0; i < 32; ++i) { const int kk = 2 * i + (lane >> 5); float v = W[(size_t)(k0 + kk) * ldw + srccol0 + (lane & 31)]; if (gs) v *= gs[k0 + kk]; scr[kk * 33 + (lane & 31)] = v; }
    LDS_WAIT(); asm volatile("" ::: "memory");
    const int c = lane & 7;
#pragma unroll
    for (int j = 0; j < 4; ++j) { const int n = (lane >> 3) + 8 * j; const LAS float* s = scr + (8 * c) * 33 + n;
        u32x4 o; o.x = cvtpk(s[0 * 33], s[1 * 33]); o.y = cvtpk(s[2 * 33], s[3 * 33]); o.z = cvtpk(s[4 * 33], s[5 * 33]); o.w = cvtpk(s[6 * 33], s[7 * 33]);
        *(u32x4*)(WT + (size_t)(dstrow0 + n) * ldt + k0 + 8 * c) = o; }
    LDS_WAIT(); asm volatile("" ::: "memory");
}

__device__ __forceinline__ void p0_prologue(const Args& A, LAS unsigned char* lds, int tid, int lane, int wave) {
    unsigned char* ws = A.ws;
    LAS float* scr = (LAS float*)(lds + wave * 16384);
    const int G = gridDim.x, gw = blockIdx.x * NWAVES + wave, NGW = G * NWAVES;
    float* stat = (float*)(ws + WS_STAT);
    for (int i = blockIdx.x * NTHREADS + tid; i < 2 * MROWS; i += G * NTHREADS) stat[MROWS + i] = 0.f;
    constexpr int I_A = 16 * 80, I_B = 16 * 32, I_C = 16 * 176, I_D = 44 * 32, I_E = 8 * 128;
    constexpr int NITEMS = I_A + I_B + I_C + I_D + I_E;
    for (int it = gw; it < NITEMS; it += NGW) {
        int r = it;
        if (r < I_A) { const int kb = r / 80, nb = r % 80, d0 = 32 * nb; int sc = d0;
            if (d0 >= 1536) { const int j = d0 - 1536, t = j >> 8, jj = j & 255; sc = (jj < 128) ? 1536 + 128 * t + jj : 2048 + 128 * t + (jj - 128); }
            transpose_item(A.w_in, DIN, sc, 64 * kb, (bf16_t*)(ws + WS_WQKV), DM, d0, A.g_mix, scr, lane); continue; } r -= I_A;
        if (r < I_B) { const int kb = r / 32, nb = r % 32; transpose_item(A.w_out, DM, 32 * nb, 64 * kb, (bf16_t*)(ws + WS_WO), DM, 32 * nb, nullptr, scr, lane); continue; } r -= I_B;
        if (r < I_C) { const int kb = r / 176, nb = r % 176, d0 = 32 * nb, t = d0 >> 8, jj = d0 & 255;
            transpose_item(jj < 128 ? A.w_gate : A.w_up, DFF, 128 * t + (jj & 127), 64 * kb, (bf16_t*)(ws + WS_WGU), DM, d0, A.g_ffn, scr, lane); continue; } r -= I_C;
        if (r < I_D) { const int kb = r / 32, nb = r % 32; transpose_item(A.w_down, DM, 32 * nb, 64 * kb, (bf16_t*)(ws + WS_WD), DFF, 32 * nb, nullptr, scr, lane); continue; } r -= I_D;
        { const int b = r >> 7, q = r & 127, kb = q >> 4, nb = q & 15;
          transpose_item(A.cache_v + (size_t)b * 512 * 512, 512, 32 * nb, 64 * kb, (bf16_t*)(ws + WS_VTS) + (size_t)b * 512 * 544, 544, 32 * nb, nullptr, scr, lane); }
    }
    bf16_t* XB = (bf16_t*)(ws + WS_XB);
    for (int m = gw; m < MROWS; m += NGW) {
        const float* xr = (m < RP) ? A.x_prompt + (size_t)m * DM : A.x_sample + (size_t)(m - RP) * DM;
        f32x4 v[4]; float s = 0.f;
#pragma unroll
        for (int j = 0; j < 4; ++j) { v[j] = ((const f32x4*)xr)[lane + 64 * j]; s += (v[j].x * v[j].x + v[j].y * v[j].y) + (v[j].z * v[j].z + v[j].w * v[j].w); }
        s = wave_sum(s);
        if (lane == 0) stat[m] = __builtin_amdgcn_rsqf(s * (1.0f / DM) + 1e-6f);
        u32x2* o = (u32x2*)(XB + (size_t)m * DM);
#pragma unroll
        for (int j = 0; j < 4; ++j) o[lane + 64 * j] = (u32x2){cvtpk(v[j].x, v[j].y), cvtpk(v[j].z, v[j].w)};
    }
    bf16_t* KS = (bf16_t*)(ws + WS_KS);
    for (int m = gw; m < 2 * 4096; m += NGW) {
        const int isv = m >= 4096, rr = m & 4095, b = rr >> 9, pos = rr & 511;
        const float* src = (isv ? A.cache_v : A.cache_k) + (size_t)rr * 512;
        const f32x4 v0 = ((const f32x4*)src)[lane], v1 = ((const f32x4*)src)[lane + 64];
        if (pos >= 32) { float* o = A.out + (isv ? OFF_VS : OFF_KS) + ((size_t)b * 512 + pos - 32) * 512; ((f32x4*)o)[lane] = v0; ((f32x4*)o)[lane + 64] = v1; }
        if (!isv) { u32x2* o = (u32x2*)(KS + ((size_t)b * 544 + pos) * 512); o[lane] = (u32x2){cvtpk(v0.x, v0.y), cvtpk(v0.z, v0.w)}; o[lane + 64] = (u32x2){cvtpk(v1.x, v1.y), cvtpk(v1.z, v1.w)}; }
    }
}

template <int NQT>
__device__ __forceinline__ void attn_unit(const bf16_t* Qp, const bf16_t* Kb, const bf16_t* VTb, int vtp, int kt0, int kt1, const LAS float* bt, bf16_t* Op, int lane) {
    const int r = lane & 31, h = lane >> 5;
    const int krow = (r & ~12) | ((r & 4) << 1) | ((r & 8) >> 1);
    constexpr float SC = 0.125f * LOG2E;
    bf16x8 qf[NQT][4];
#pragma unroll
    for (int c = 0; c < NQT; ++c)
#pragma unroll
        for (int s = 0; s < 4; ++s) qf[c][s] = *(const bf16x8*)(Qp + (size_t)(32 * c + r) * 512 + 16 * s + 8 * h);
    f32x16 o[2][NQT]; float mrun[NQT], lrun[NQT];
#pragma unroll
    for (int c = 0; c < NQT; ++c) { mrun[c] = -1e30f; lrun[c] = 0.f;
#pragma unroll
        for (int dt = 0; dt < 2; ++dt)
#pragma unroll
            for (int i = 0; i < 16; ++i) o[dt][c][i] = 0.f; }
    const bf16_t* kp = Kb + (long)krow * 512 + 8 * h;
    const bf16_t* vp = VTb + (long)r * vtp + 8 * h;
    bf16x8 kf[4];
#pragma unroll
    for (int s = 0; s < 4; ++s) kf[s] = *(const bf16x8*)(kp + (long)kt0 * 32 * 512 + 16 * s);
    const float cbias = bt[256];
    for (int kt = kt0; kt < kt1; ++kt) {
        bf16x8 vf[2][2];
#pragma unroll
        for (int dt = 0; dt < 2; ++dt)
#pragma unroll
            for (int s = 0; s < 2; ++s) vf[dt][s] = *(const bf16x8*)(vp + (long)(32 * dt) * vtp + 32 * kt + 16 * s);
        const int ktn = (kt + 1 < kt1) ? kt + 1 : kt;
        bf16x8 kn[4];
#pragma unroll
        for (int s = 0; s < 4; ++s) kn[s] = *(const bf16x8*)(kp + (long)ktn * 32 * 512 + 16 * s);
        f32x16 sa[NQT];
#pragma unroll
        for (int c = 0; c < NQT; ++c) {
#pragma unroll
            for (int i = 0; i < 16; ++i) sa[c][i] = 0.f;
#pragma unroll
            for (int s = 0; s < 4; ++s) sa[c] = __builtin_amdgcn_mfma_f32_32x32x16_bf16(kf[s], qf[c][s], sa[c], 0, 0, 0); }
        bf16x8 pf[NQT][2];
#pragma unroll
        for (int c = 0; c < NQT; ++c) {
            if (kt <= 11) {
#pragma unroll
                for (int i = 0; i < 16; ++i) sa[c][i] = sa[c][i] * SC + cbias;
            } else {
                const int base = 32 * c + r - 32 * kt - 8 * h + 512;
#pragma unroll
                for (int i = 0; i < 16; ++i) { const int koff = (i & 3) + 4 * ((i >> 2) & 1) + 16 * (i >> 3); int rel = base - koff; rel = rel > 128 ? 128 : rel; sa[c][i] = sa[c][i] * SC + bt[rel + 128]; }
            }
            float mx = sa[c][0];
#pragma unroll
            for (int i = 1; i < 16; ++i) mx = fmaxf(mx, sa[c][i]);
            mx = fmaxf(mx, __shfl_xor(mx, 32));
            const float mnew = fmaxf(mrun[c], mx), alpha = __builtin_amdgcn_exp2f(mrun[c] - mnew);
            mrun[c] = mnew; float ls = 0.f;
#pragma unroll
            for (int i = 0; i < 16; ++i) { sa[c][i] = __builtin_amdgcn_exp2f(sa[c][i] - mnew); ls += sa[c][i]; }
            lrun[c] = lrun[c] * alpha + ls;
#pragma unroll
            for (int dt = 0; dt < 2; ++dt)
#pragma unroll
                for (int i = 0; i < 16; ++i) o[dt][c][i] *= alpha;
#pragma unroll
            for (int s = 0; s < 2; ++s) { u32x4 w; w.x = cvtpk(sa[c][8 * s + 0], sa[c][8 * s + 1]); w.y = cvtpk(sa[c][8 * s + 2], sa[c][8 * s + 3]); w.z = cvtpk(sa[c][8 * s + 4], sa[c][8 * s + 5]); w.w = cvtpk(sa[c][8 * s + 6], sa[c][8 * s + 7]);
                pf[c][s] = __builtin_bit_cast(bf16x8, w); }
        }
#pragma unroll
        for (int dt = 0; dt < 2; ++dt)
#pragma unroll
            for (int c = 0; c < NQT; ++c)
#pragma unroll
                for (int s = 0; s < 2; ++s) o[dt][c] = __builtin_amdgcn_mfma_f32_32x32x16_bf16(vf[dt][s], pf[c][s], o[dt][c], 0, 0, 0);
#pragma unroll
        for (int s = 0; s < 4; ++s) kf[s] = kn[s];
    }
#pragma unroll
    for (int c = 0; c < NQT; ++c) { const float l = lrun[c] + __shfl_xor(lrun[c], 32); const float inv = 1.0f / l;
#pragma unroll
        for (int dt = 0; dt < 2; ++dt)
#pragma unroll
            for (int g = 0; g < 4; ++g) { const int d = 32 * dt + 8 * g + 4 * h;
                *(u32x2*)(Op + (size_t)(32 * c + r) * 1024 + d) = (u32x2){cvtpk(o[dt][c][4 * g] * inv, o[dt][c][4 * g + 1] * inv), cvtpk(o[dt][c][4 * g + 2] * inv, o[dt][c][4 * g + 3] * inv)}; } }
}

__device__ __forceinline__ float bf_lo(unsigned w) { return __builtin_bit_cast(float, w << 16); }
__device__ __forceinline__ float bf_hi(unsigned w) { return __builtin_bit_cast(float, w & 0xffff0000u); }

__device__ __forceinline__ void conv_unit(const Args& A, int unit, LAS float* red, int tid, int lane, int wave) {
    const bf16_t* U = (const bf16_t*)(A.ws + WS_U); bf16_t* OC = (bf16_t*)(A.ws + WS_OC);
    const bool sample = unit >= 1024;
    const int b = sample ? (unit - 1024) >> 1 : unit >> 7, t0 = sample ? ((unit - 1024) & 1) * 16 : (unit & 127) * 16;
    const int rowbase = sample ? RP + b * 32 : b * TS;
    const int tg = tid >> 8, cp = tid & 255, c = 2 * cp, tb = t0 + 8 * tg;
    float in0[38], in1[38];
#pragma unroll
    for (int i = 0; i < 38; ++i) { const int t = tb - 30 + i; const int tc = t < 0 ? 0 : t;
        const unsigned w = *(const unsigned*)(U + (size_t)(rowbase + tc) * 512 + c);
        float a0 = bf_lo(w), a1 = bf_hi(w);
        if (i < 30) { if (t < 0) { a0 = 0.f; a1 = 0.f; if (sample) { const f32x2 sv = *(const f32x2*)(A.state_conv + ((size_t)b * 30 + 30 + t) * 512 + c); a0 = sv.x; a1 = sv.y; } } }
        in0[i] = a0; in1[i] = a1; }
    const f32x2 bd = *(const f32x2*)(A.b_dw + c);
    float y0[8], y1[8];
#pragma unroll
    for (int k = 0; k < 8; ++k) { y0[k] = bd.x; y1[k] = bd.y; }
#pragma unroll
    for (int j = 0; j < 31; ++j) { const f32x2 w = *(const f32x2*)(A.w_dw + (size_t)j * 512 + c);
#pragma unroll
        for (int k = 0; k < 8; ++k) { y0[k] += w.x * in0[k + j]; y1[k] += w.y * in1[k + j]; } }
    float s1[8], s2[8];
#pragma unroll
    for (int k = 0; k < 8; ++k) { s1[k] = wave_sum(y0[k] + y1[k]); s2[k] = wave_sum(y0[k] * y0[k] + y1[k] * y1[k]); }
    if (lane == 0) {
#pragma unroll
        for (int k = 0; k < 8; ++k) { red[wave * 16 + k] = s1[k]; red[wave * 16 + 8 + k] = s2[k]; } }
    __syncthreads();
    const f32x2 lg = *(const f32x2*)(A.ln_g + c), lb = *(const f32x2*)(A.ln_b + c);
#pragma unroll
    for (int k = 0; k < 8; ++k) {
        float S1 = 0.f, S2 = 0.f;
#pragma unroll
        for (int w = 0; w < 4; ++w) { S1 += red[(4 * tg + w) * 16 + k]; S2 += red[(4 * tg + w) * 16 + 8 + k]; }
        const float mean = S1 * (1.0f / 512.0f), var = S2 * (1.0f / 512.0f) - mean * mean, rstd = __builtin_amdgcn_rsqf(var + 1e-5f);
        const float z0 = (y0[k] - mean) * rstd * lg.x + lb.x, z1 = (y1[k] - mean) * rstd * lg.y + lb.y;
        const float o0 = z0 * fast_sigmoid(z0), o1 = z1 * fast_sigmoid(z1);
        *(unsigned*)(OC + (size_t)(rowbase + tb + k) * 1024 + 512 + c) = cvtpk(o0, o1);
    }
    __syncthreads();
}

__global__ void __launch_bounds__(NTHREADS, 2) fwd_megakernel(Args A) {
    extern __shared__ __attribute__((aligned(16))) unsigned char lds_raw[];
    cg::grid_group grid = cg::this_grid();
    LAS unsigned char* lds = (LAS unsigned char*)lds_raw;
#define FRESH_TID() int tid_ = threadIdx.x; asm volatile("" : "+v"(tid_)); const int tid = tid_, lane = tid & 63, wave = __builtin_amdgcn_readfirstlane(tid >> 6); (void)lane; (void)wave;
    const int G = gridDim.x;
    unsigned char* ws = A.ws;
    float* stat = (float*)(ws + WS_STAT);
    bf16_t* XB = (bf16_t*)(ws + WS_XB);

    { FRESH_TID(); p0_prologue(A, lds, tid, lane, wave); }
    grid.sync();

    {
        pg8::Gemm g{XB, (const bf16_t*)(ws + WS_WQKV), MROWS, DIN, DM}; pg8::StaticOrder S; S.init(MROWS, DIN, G, (int)blockIdx.x);
        pg8::EpiQKV E{stat, (bf16_t*)(ws + WS_Q), (bf16_t*)(ws + WS_KP), (bf16_t*)(ws + WS_KS), (bf16_t*)(ws + WS_VT), (bf16_t*)(ws + WS_VTS), (bf16_t*)(ws + WS_U), A.out};
        pg8::gemm_phase<pg8::EpiQKV, pg8::StaticOrder, true, true>(lds, g, S, E);
    }
    grid.sync();

    {
        FRESH_TID();
        LAS float* bt = (LAS float*)lds; LAS float* red = (LAS float*)(lds + 16384);
        for (int i = tid; i < 8 * 257; i += NTHREADS) bt[i] = A.rel_table[i] * LOG2E;
        __syncthreads();
        const bf16_t* Q = (const bf16_t*)(ws + WS_Q); const bf16_t* KP = (const bf16_t*)(ws + WS_KP); const bf16_t* KS = (const bf16_t*)(ws + WS_KS);
        const bf16_t* VT = (const bf16_t*)(ws + WS_VT); const bf16_t* VTS = (const bf16_t*)(ws + WS_VTS); bf16_t* OC = (bf16_t*)(ws + WS_OC);
        for (int pc = blockIdx.x; pc < 256; pc += G) {
            const int b = pc >> 5, c = pc & 31, hd = wave;
            const long row0 = (long)b * TS + 64 * c;
            attn_unit<2>(Q + row0 * 512 + hd * 64, KP + (row0 - 512) * 512 + hd * 64, VT + ((long)b * 512 + hd * 64) * TS + 64 * c - 512, TS, (16 - 2 * c) > 0 ? (16 - 2 * c) : 0, 18,
                         bt + hd * 257, OC + row0 * 1024 + hd * 64, lane);
            if (c == 0) { const long rs = RP + b * 32;
                attn_unit<1>(Q + rs * 512 + hd * 64, KS + (long)b * 544 * 512 + hd * 64, VTS + ((long)b * 512 + hd * 64) * 544, 544, 0, 17, bt + hd * 257, OC + rs * 1024 + hd * 64, lane); }
        }
        __syncthreads();
        for (int u = blockIdx.x; u < 1040; u += G) conv_unit(A, u, red, tid, lane, wave);
    }
    grid.sync();

    {
        pg8::Gemm g{(const bf16_t*)(ws + WS_OC), (const bf16_t*)(ws + WS_WO), MROWS, DM, DM}; pg8::StaticOrder S; S.init(MROWS, DM, G, (int)blockIdx.x);
        pg8::EpiRes<true> E{A.x_prompt, A.x_sample, A.out, XB, stat + MROWS};
        pg8::gemm_phase<pg8::EpiRes<true>, pg8::StaticOrder, true, true>(lds, g, S, E);
    }
    grid.sync();

    {
        pg8::Gemm g{XB, (const bf16_t*)(ws + WS_WGU), MROWS, NGU, DM}; pg8::StaticOrder S; S.init(MROWS, NGU, G, (int)blockIdx.x);
        pg8::EpiGU E{stat + MROWS, (bf16_t*)(ws + WS_HM)};
        pg8::gemm_phase<pg8::EpiGU, pg8::StaticOrder, true, true>(lds, g, S, E);
    }
    grid.sync();

    {
        pg8::Gemm g{(const bf16_t*)(ws + WS_HM), (const bf16_t*)(ws + WS_WD), MROWS, DM, DFF}; pg8::StaticOrder S; S.init(MROWS, DM, G, (int)blockIdx.x);
        pg8::EpiRes<false> E{A.out, A.out + (size_t)RP * DM, A.out, nullptr, stat + 2 * MROWS};
        pg8::gemm_phase<pg8::EpiRes<false>, pg8::StaticOrder, true, true>(lds, g, S, E);
    }
    grid.sync();

    {
        FRESH_TID();
        const int gw = blockIdx.x * NWAVES + wave, NGW = G * NWAVES;
        f32x4 gf[4];
#pragma unroll
        for (int j = 0; j < 4; ++j) gf[j] = ((const f32x4*)A.g_final)[lane + 64 * j];
        for (int m = gw; m < MROWS; m += NGW) {
            f32x4* row = (f32x4*)(A.out + (size_t)m * DM);
            const float rs = __builtin_amdgcn_rsqf(stat[2 * MROWS + m] * (1.0f / DM) + 1e-6f);
#pragma unroll
            for (int j = 0; j < 4; ++j) row[lane + 64 * j] = row[lane + 64 * j] * rs * gf[j];
        }
    }
}

extern "C" void kernel_launch(void* const* d_in, const int* in_sizes, int n_in, void* d_out, int out_size, void* d_ws, size_t ws_size, hipStream_t stream) {
    static int grid = 0;
    if (grid == 0) {
        int dev = 0, cus = 0, per_cu = 0;
        hipGetDevice(&dev);
        hipDeviceGetAttribute(&cus, hipDeviceAttributeMultiprocessorCount, dev);
        if (hipFuncSetAttribute((const void*)fwd_megakernel, hipFuncAttributeMaxDynamicSharedMemorySize, LDS_BYTES) != hipSuccess) { fprintf(stderr, "hipFuncSetAttribute failed\n"); }
        hipOccupancyMaxActiveBlocksPerMultiprocessor(&per_cu, (const void*)fwd_megakernel, NTHREADS, LDS_BYTES);
        (void)hipGetLastError();
        if (per_cu < 1) per_cu = 1;
        grid = cus * per_cu;
    }
    Args a{};
    a.x_prompt = (const float*)d_in[0]; a.x_sample = (const float*)d_in[1]; a.cache_k = (const float*)d_in[2]; a.cache_v = (const float*)d_in[3]; a.state_conv = (const float*)d_in[4];
    a.g_mix = (const float*)d_in[5]; a.w_in = (const float*)d_in[6]; a.rel_table = (const float*)d_in[7]; a.w_dw = (const float*)d_in[8]; a.b_dw = (const float*)d_in[9];
    a.ln_g = (const float*)d_in[10]; a.ln_b = (const float*)d_in[11]; a.w_out = (const float*)d_in[12]; a.g_ffn = (const float*)d_in[13]; a.w_gate = (const float*)d_in[14];
    a.w_up = (const float*)d_in[15]; a.w_down = (const float*)d_in[16]; a.g_final = (const float*)d_in[17];
    a.out = (float*)d_out; a.ws = (unsigned char*)d_ws;
    void* args[] = {&a};
    hipError_t e = hipLaunchCooperativeKernel((const void*)fwd_megakernel, dim3(grid), dim3(NTHREADS), args, LDS_BYTES, stream);
    if (e != hipSuccess) fprintf(stderr, "cooperative launch failed: %s (grid %d)\n", hipGetErrorString(e), grid);
}
```

```cpp
#include <hip/hip_runtime.h>
#include <hip/hip_cooperative_groups.h>
#include <cstdio>
#include <cstdint>
namespace cg = cooperative_groups;
namespace pg8 {
#define PG8_LAS __attribute__((address_space(3)))
typedef unsigned short bf16_t;
typedef short bf16x8 __attribute__((ext_vector_type(8)));
typedef float f32x4 __attribute__((ext_vector_type(4)));
typedef unsigned u32x4 __attribute__((ext_vector_type(4)));
constexpr int BM = 256, BK = 64, HALF = 128, HTB = HALF * BK * 2  , STAGE_BYTES = 8 * HTB, NXCD = 8, WGM = 8;

__host__ __device__ __forceinline__ int lds_byte(int r, int c) { const int st = (r >> 4) * 2 + (c >> 5), rr = r & 15, cc = c & 31, ob = rr * 64 + cc * 2; return st * 1024 + (ob ^ (((ob >> 9) & 1) << 5)); }
__host__ __device__ __forceinline__ void stage_rc(int b, int& R, int& C) { const int st = b / 1024, sb = b % 1024, swz = sb ^ (((sb >> 9) & 1) << 5); R = (st >> 1) * 16 + swz / 64; C = (st & 1) * 32 + (swz % 64) / 2; }
__host__ __device__ __forceinline__ int perm32(int rho) { const int n = rho >> 4, i = rho & 15; return 8 * (i >> 2) + 4 * n + (i & 3); }

struct Unit { int pm, pn; };
struct Gemm { const bf16_t* A; const bf16_t* Bt; int M, N, K; };

struct StaticOrder {
    int nM, nN, nwg, G, c;
    __host__ __device__ void init(int M, int N, int G_, int c_) { nM = M / BM; nN = N / BM; nwg = nM * nN; G = G_; c = c_; }
    __host__ __device__ bool next(int i, Unit& u) const {
        const long L = (long)i * G + c; if (L >= nwg) return false;
        int wgid = (int)L; { const int q = nwg / NXCD, r = nwg % NXCD, xcd = wgid % NXCD, off = wgid / NXCD; wgid = (xcd < r ? xcd * (q + 1) : r * (q + 1) + (xcd - r) * q) + off; }
        const int nig = WGM * nN, gid = wgid / nig, fm = gid * WGM, gsz = (nM - fm) < WGM ? (nM - fm) : WGM;
        u.pm = fm + ((wgid % nig) % gsz); u.pn = (wgid % nig) / gsz; return true;
    }
    __device__ __forceinline__ void a_ready(const Unit&) const {}
    __device__ __forceinline__ void done(const Unit&) const {}
};

__device__ __forceinline__ unsigned cvt_pk_bf16(float lo, float hi) { unsigned r; asm volatile("v_cvt_pk_bf16_f32 %0, %1, %2" : "=v"(r) : "v"(lo), "v"(hi)); return r; }
typedef float f32x2 __attribute__((ext_vector_type(2)));

constexpr int R_PROMPT = 16384, T_SEQ = 2048;
constexpr size_t OFF_Y = 0, OFF_KP = 17039360, OFF_VP = 19136512, OFF_CP = 21233664, OFF_KS = 21356544, OFF_VS = 23453696, OFF_CS = 25550848;

__device__ __forceinline__ u32x4 pack8(const f32x4 a, const f32x4 b) { u32x4 w; w.x = cvt_pk_bf16(a[0], a[1]); w.y = cvt_pk_bf16(a[2], a[3]); w.z = cvt_pk_bf16(b[0], b[1]); w.w = cvt_pk_bf16(b[2], b[3]); return w; }
__device__ __forceinline__ float fast_sigmoid(float g) { return __builtin_amdgcn_rcpf(1.0f + __builtin_amdgcn_exp2f(-1.4426950408889634f * g)); }

struct EpiQKV {
    static constexpr bool PERM = true, AFTER_DRAIN = false;
    const float* rstd0; bf16_t* Q; bf16_t* KP; bf16_t* KS; bf16_t* VT; bf16_t* VTS; bf16_t* U; bf16_t* US; float* out;
    __device__ __forceinline__ void operator()(const f32x4 (&acc)[2][2][4][2], const Unit& u, int wr, int wc, int fr, int fq) const {
        asm volatile("" : "+v"(fr), "+v"(fq));
        const int rbase = u.pm * BM + wr * 64 + fr;
        const bool sample = (u.pm == 64);
        const int kind = u.pn >> 1;
        const int b = sample ? 0 : (u.pm >> 3);
        if (kind == 0) {
            const int col0 = u.pn * BM + wc * 32 + 8 * fq;
#pragma unroll
            for (int ai = 0; ai < 2; ++ai)
#pragma unroll
                for (int m = 0; m < 4; ++m) { const int r = rbase + ai * HALF + m * 16; const float rs = rstd0[r];
#pragma unroll
                    for (int bj = 0; bj < 2; ++bj) *(u32x4*)(Q + (size_t)r * 512 + col0 + bj * HALF) = pack8(acc[ai][bj][m][0] * rs, acc[ai][bj][m][1] * rs); }
        } else if (kind == 1 || kind == 2) {
            const int col0 = (u.pn & 1) * BM + wc * 32 + 8 * fq;
            const bool isv = (kind == 2);
            const bool keep = sample || ((u.pm & 7) >= 6);
            float* ofp = out + (sample ? (isv ? OFF_VS : OFF_KS) : (isv ? OFF_VP : OFF_KP));
#pragma unroll
            for (int ai = 0; ai < 2; ++ai)
#pragma unroll
                for (int m = 0; m < 4; ++m) { const int r = rbase + ai * HALF + m * 16; const float rs = rstd0[r];
                    int sb, st, orow;
                    if (sample) { const int rr = r - R_PROMPT; sb = rr >> 5; st = 512 + (rr & 31); orow = sb * 512 + 480 + (rr & 31); }
                    else { sb = b; st = r - b * T_SEQ; orow = b * 512 + st - 1536; }
#pragma unroll
                    for (int bj = 0; bj < 2; ++bj) { const f32x4 v0 = acc[ai][bj][m][0] * rs, v1 = acc[ai][bj][m][1] * rs; const int c = col0 + bj * HALF;
                        if (keep) { *(f32x4*)(ofp + (size_t)orow * 512 + c) = v0; *(f32x4*)(ofp + (size_t)orow * 512 + c + 4) = v1; }
                        const u32x4 w = pack8(v0, v1);
                        if (!isv) { bf16_t* kd = sample ? KS + ((size_t)sb * 544 + st) * 512 : KP + (size_t)r * 512; *(u32x4*)(kd + c) = w; }
                        else { bf16_t* vd = sample ? VTS + ((size_t)sb * 512 + c) * 544 + st : VT + ((size_t)sb * 512 + c) * T_SEQ + st; const int vp = sample ? 544 : T_SEQ;
                            vd[0] = (bf16_t)(w.x & 0xffffu); vd[vp] = (bf16_t)(w.x >> 16); vd[2 * vp] = (bf16_t)(w.y & 0xffffu); vd[3 * vp] = (bf16_t)(w.y >> 16);
                            vd[4 * vp] = (bf16_t)(w.z & 0xffffu); vd[5 * vp] = (bf16_t)(w.z >> 16); vd[6 * vp] = (bf16_t)(w.w & 0xffffu); vd[7 * vp] = (bf16_t)(w.w >> 16); } } }
        } else {
            const int ch0 = (u.pn - 6) * HALF + wc * 32 + 8 * fq;
            const bool tail = sample || ((u.pm & 7) == 7);
#pragma unroll
            for (int ai = 0; ai < 2; ++ai)
#pragma unroll
                for (int m = 0; m < 4; ++m) { const int r = rbase + ai * HALF + m * 16; const float rs = rstd0[r];
                    f32x4 v[2];
#pragma unroll
                    for (int n = 0; n < 2; ++n) { const f32x4 a = acc[ai][0][m][n] * rs, g = acc[ai][1][m][n] * rs;
                        v[n] = (f32x4){a[0] * fast_sigmoid(g[0]), a[1] * fast_sigmoid(g[1]), a[2] * fast_sigmoid(g[2]), a[3] * fast_sigmoid(g[3])}; }
                    { bf16_t* ud = sample ? US + ((size_t)((r - R_PROMPT) >> 5) * 62 + 30 + ((r - R_PROMPT) & 31)) * 512 : U + (size_t)r * 512; *(u32x4*)(ud + ch0) = pack8(v[0], v[1]); }
                    if (tail) { int orow = -1;
                        if (sample) { const int rr = r - R_PROMPT; if ((rr & 31) >= 2) orow = (rr >> 5) * 30 + (rr & 31) - 2; }
                        else { const int st = r - b * T_SEQ; if (st >= T_SEQ - 30) orow = b * 30 + st - (T_SEQ - 30); }
                        if (orow >= 0) { float* o = out + (sample ? OFF_CS : OFF_CP) + (size_t)orow * 512 + ch0; *(f32x4*)o = v[0]; *(f32x4*)(o + 4) = v[1]; } } }
        }
    }
};

template <bool BF> struct EpiRes {
    static constexpr bool PERM = true, AFTER_DRAIN = false;
    const float* basep; const float* bases; float* outf; bf16_t* outb; float* ss;
    __device__ __forceinline__ void operator()(const f32x4 (&acc)[2][2][4][2], const Unit& u, int wr, int wc, int fr, int fq) const {
        asm volatile("" : "+v"(fr), "+v"(fq));
        const int rbase = u.pm * BM + wr * 64 + fr; const int col0 = u.pn * BM + wc * 32 + 8 * fq;
        const float* bp = (u.pm == 64) ? bases - (size_t)R_PROMPT * 1024 : basep;
#pragma unroll
        for (int ai = 0; ai < 2; ++ai)
#pragma unroll
            for (int m = 0; m < 4; ++m) { const int r = rbase + ai * HALF + m * 16; const size_t off = (size_t)r * 1024 + col0; float s = 0.f;
#pragma unroll
                for (int bj = 0; bj < 2; ++bj) { const f32x4 xa = *(const f32x4*)(bp + off + bj * HALF), xb = *(const f32x4*)(bp + off + bj * HALF + 4);
                    const f32x4 v0 = acc[ai][bj][m][0] + xa, v1 = acc[ai][bj][m][1] + xb;
                    *(f32x4*)(outf + off + bj * HALF) = v0; *(f32x4*)(outf + off + bj * HALF + 4) = v1;
                    if (BF) *(u32x4*)(outb + off + bj * HALF) = pack8(v0, v1);
                    s += (v0[0] * v0[0] + v0[1] * v0[1]) + (v0[2] * v0[2] + v0[3] * v0[3]) + (v1[0] * v1[0] + v1[1] * v1[1]) + (v1[2] * v1[2] + v1[3] * v1[3]); }
                s += __shfl_xor(s, 16); s += __shfl_xor(s, 32);
                if (fq == 0) (void)__hip_atomic_fetch_add(ss + r, s, __ATOMIC_RELAXED, __HIP_MEMORY_SCOPE_AGENT); }
    }
};

struct EpiGU {
    static constexpr bool PERM = true, AFTER_DRAIN = false;
    const float* ss1; bf16_t* HM;
    __device__ __forceinline__ void operator()(const f32x4 (&acc)[2][2][4][2], const Unit& u, int wr, int wc, int fr, int fq) const {
        asm volatile("" : "+v"(fr), "+v"(fq));
        const int rbase = u.pm * BM + wr * 64 + fr; const int ch0 = u.pn * HALF + wc * 32 + 8 * fq;
#pragma unroll
        for (int ai = 0; ai < 2; ++ai)
#pragma unroll
            for (int m = 0; m < 4; ++m) { const int r = rbase + ai * HALF + m * 16; const float rs = __builtin_amdgcn_rsqf(ss1[r] * (1.0f / 1024.0f) + 1e-6f);
                f32x4 v[2];
#pragma unroll
                for (int n = 0; n < 2; ++n) { const f32x4 g = acc[ai][0][m][n] * rs, up = acc[ai][1][m][n] * rs;
                    v[n] = (f32x4){g[0] * fast_sigmoid(g[0]) * up[0], g[1] * fast_sigmoid(g[1]) * up[1], g[2] * fast_sigmoid(g[2]) * up[2], g[3] * fast_sigmoid(g[3]) * up[3]}; }
                *(u32x4*)(HM + (size_t)r * 2816 + ch0) = pack8(v[0], v[1]); }
    }
};
template <class Epi, class Sched, bool ALIGN_EPI = false, bool SP2 = false>
__device__ __forceinline__ void gemm_phase(PG8_LAS unsigned char* lds, const Gemm g, const Sched& S, const Epi& E) {
    int tid_ = threadIdx.x; asm volatile("" : "+v"(tid_)); const int tid = tid_, wid = __builtin_amdgcn_readfirstlane(tid >> 6), lane = tid & 63, wr = wid >> 2, wc = wid & 3, fr = lane & 15, fq = lane >> 4;
    const int K = g.K, nt = K / BK;
    unsigned voffA[2], voffB[2];
#pragma unroll
    for (int i = 0; i < 2; ++i) { int R, C; stage_rc(tid * 16 + i * 8192, R, C); const int Rb = Epi::PERM ? ((R & ~31) + perm32(R & 31)) : R;
        voffA[i] = (unsigned)(R * K + C) * 2u; voffB[i] = (unsigned)(Rb * K + C) * 2u; }
    const size_t kstep = (size_t)(BK * 2);
    const size_t hstep = (size_t)HALF * K * 2;
    const size_t tstep = 2 * hstep;
    const unsigned ldsw = (unsigned)wid * 1024u;
    const int aoff = lds_byte(wr * 64 + fr, fq * 8), boff = lds_byte(wc * 32 + fr, fq * 8);
#define PG8_SA(b, h) (((b) * 2 + (h)) * HTB)
#define PG8_SB(b, h) ((4 + (b) * 2 + (h)) * HTB)
#define PG8_STAGE(bufoff, gbase, voff) do { _Pragma("unroll") for (int _i = 0; _i < 2; ++_i) \
        __builtin_amdgcn_global_load_lds((const unsigned*)((const char*)(gbase) + (voff)[_i]), (PG8_LAS unsigned*)(lds + (bufoff) + ldsw + _i * 8192), 16, 0, 0); } while (0)
#define PG8_LDA(dst, b, h) do { _Pragma("unroll") for (int m = 0; m < 4; ++m) _Pragma("unroll") for (int k = 0; k < 2; ++k) dst[m][k] = *(const PG8_LAS bf16x8*)(lds + PG8_SA(b, h) + aoff + m * 2048 + k * 1024); } while (0)
#define PG8_LDB(dst, b, h) do { _Pragma("unroll") for (int n = 0; n < 2; ++n) _Pragma("unroll") for (int k = 0; k < 2; ++k) dst[n][k] = *(const PG8_LAS bf16x8*)(lds + PG8_SB(b, h) + boff + n * 2048 + k * 1024); } while (0)
#define PG8_MMA(ai, bj, At, Bt) do { __builtin_amdgcn_s_setprio(1); _Pragma("unroll") for (int m = 0; m < 4; ++m) _Pragma("unroll") for (int n = 0; n < 2; ++n) _Pragma("unroll") for (int k = 0; k < 2; ++k) \
        acc[ai][bj][m][n] = __builtin_amdgcn_mfma_f32_16x16x32_bf16(Bt[n][k], At[m][k], acc[ai][bj][m][n], 0, 0, 0); __builtin_amdgcn_s_setprio(0); } while (0)
#define PG8_WAIT_V(n) asm volatile("s_waitcnt vmcnt(" #n ")" ::: "memory")
#define PG8_WAIT_L(n) asm volatile("s_waitcnt lgkmcnt(" #n ")" ::: "memory")
#define PG8_BAR __builtin_amdgcn_s_barrier()
#define PG8_SCHED __builtin_amdgcn_sched_barrier(0)
    Unit cur, nxt; int ui = 0;
    if (!S.next(0, cur)) return;
    f32x4 acc[2][2][4][2];
#pragma unroll
    for (int a = 0; a < 2; ++a)
#pragma unroll
        for (int b = 0; b < 2; ++b)
#pragma unroll
            for (int m = 0; m < 4; ++m)
#pragma unroll
                for (int n = 0; n < 2; ++n) acc[a][b][m][n] = (f32x4){0.f, 0.f, 0.f, 0.f};
    bf16x8 At[4][2], B0[2][2], B1[2][2];
    const char* cA = (const char*)g.A + (size_t)cur.pm * tstep; const char* cB = (const char*)g.Bt + (size_t)cur.pn * tstep;
    S.a_ready(cur);
    if constexpr (SP2) {
        PG8_STAGE(PG8_SB(0, 0), cB, voffB); PG8_STAGE(PG8_SB(0, 1), cB + hstep, voffB); PG8_STAGE(PG8_SA(0, 0), cA, voffA); PG8_STAGE(PG8_SA(0, 1), cA + hstep, voffA);
        if (wr == 1) PG8_BAR;
        PG8_WAIT_V(2); PG8_BAR;
        PG8_STAGE(PG8_SB(1, 0), cB + kstep, voffB); PG8_STAGE(PG8_SA(1, 0), cA + kstep, voffA); PG8_STAGE(PG8_SB(1, 1), cB + hstep + kstep, voffB);
        PG8_WAIT_V(6); PG8_BAR;
    } else {
        PG8_STAGE(PG8_SB(0, 0), cB, voffB); PG8_STAGE(PG8_SA(0, 0), cA, voffA); PG8_STAGE(PG8_SB(0, 1), cB + hstep, voffB); PG8_STAGE(PG8_SA(0, 1), cA + hstep, voffA);
        if (wr == 1) PG8_BAR;
        PG8_WAIT_V(4); PG8_BAR;
        PG8_STAGE(PG8_SB(1, 0), cB + kstep, voffB); PG8_STAGE(PG8_SA(1, 0), cA + kstep, voffA); PG8_STAGE(PG8_SB(1, 1), cB + hstep + kstep, voffB);
        PG8_WAIT_V(6); PG8_BAR;
    }
    for (;;) {
        const bool has_next = S.next(ui + 1, nxt);
        const char* nA = has_next ? (const char*)g.A + (size_t)nxt.pm * tstep : cA; const char* nB = has_next ? (const char*)g.Bt + (size_t)nxt.pn * tstep : cB;
        for (int t = 0; t < nt; t += 2) {
            const bool last = (t == nt - 2);
            const char* a1 = cA + (size_t)(t + 1) * kstep;
            const char* a2 = last ? nA : cA + (size_t)(t + 2) * kstep; const char* b2 = last ? nB : cB + (size_t)(t + 2) * kstep;
            const char* a3 = a2 + kstep; const char* b3 = b2 + kstep;
            if (last && has_next) S.a_ready(nxt);
            if constexpr (SP2) {
            PG8_LDB(B0, 0, 0); PG8_LDB(B1, 0, 1); PG8_SCHED; PG8_LDA(At, 0, 0); PG8_STAGE(PG8_SA(1, 1), a1 + hstep, voffA);
            PG8_WAIT_V(8); PG8_WAIT_L(0); PG8_BAR; PG8_MMA(0, 0, At, B0); PG8_MMA(0, 1, At, B1); PG8_BAR; PG8_SCHED;
            PG8_LDA(At, 0, 1); PG8_STAGE(PG8_SB(0, 0), b2, voffB); PG8_STAGE(PG8_SB(0, 1), b2 + hstep, voffB); PG8_STAGE(PG8_SA(0, 0), a2, voffA);
            PG8_WAIT_V(8); PG8_WAIT_L(0); PG8_BAR; PG8_MMA(1, 0, At, B0); PG8_MMA(1, 1, At, B1); PG8_BAR; PG8_SCHED;
            PG8_LDB(B0, 1, 0); PG8_LDB(B1, 1, 1); PG8_SCHED; PG8_LDA(At, 1, 0); PG8_STAGE(PG8_SA(0, 1), a2 + hstep, voffA);
            PG8_WAIT_V(8); PG8_WAIT_L(0); PG8_BAR; PG8_MMA(0, 0, At, B0); PG8_MMA(0, 1, At, B1); PG8_BAR; PG8_SCHED;
            PG8_LDA(At, 1, 1); PG8_STAGE(PG8_SB(1, 0), b3, voffB); PG8_STAGE(PG8_SB(1, 1), b3 + hstep, voffB); PG8_STAGE(PG8_SA(1, 0), a3, voffA);
            PG8_WAIT_V(8); PG8_WAIT_L(0); PG8_BAR; PG8_MMA(1, 0, At, B0); PG8_MMA(1, 1, At, B1); PG8_BAR; PG8_SCHED;
            } else {
            PG8_LDB(B0, 0, 0); PG8_SCHED; PG8_LDA(At, 0, 0); PG8_STAGE(PG8_SA(1, 1), a1 + hstep, voffA);
            PG8_WAIT_L(8); PG8_BAR; PG8_WAIT_L(0); PG8_MMA(0, 0, At, B0); PG8_BAR; PG8_SCHED;
            PG8_LDB(B1, 0, 1); PG8_STAGE(PG8_SB(0, 0), b2, voffB);
            PG8_BAR; PG8_WAIT_L(0); PG8_MMA(0, 1, At, B1); PG8_BAR;
            PG8_LDA(At, 0, 1); PG8_STAGE(PG8_SA(0, 0), a2, voffA);
            PG8_BAR; PG8_WAIT_L(0); PG8_MMA(1, 0, At, B0); PG8_BAR; PG8_SCHED;
            PG8_STAGE(PG8_SB(0, 1), b2 + hstep, voffB);
            PG8_WAIT_V(6); PG8_BAR; PG8_MMA(1, 1, At, B1); PG8_BAR;
            PG8_LDB(B0, 1, 0); PG8_SCHED; PG8_LDA(At, 1, 0); PG8_STAGE(PG8_SA(0, 1), a2 + hstep, voffA);
            PG8_WAIT_L(8); PG8_BAR; PG8_WAIT_L(0); PG8_MMA(0, 0, At, B0); PG8_BAR; PG8_SCHED;
            PG8_LDB(B1, 1, 1); PG8_STAGE(PG8_SB(1, 0), b3, voffB);
            PG8_BAR; PG8_WAIT_L(0); PG8_MMA(0, 1, At, B1); PG8_BAR;
            PG8_LDA(At, 1, 1); PG8_STAGE(PG8_SA(1, 0), a3, voffA);
            PG8_BAR; PG8_WAIT_L(0); PG8_MMA(1, 0, At, B0); PG8_BAR; PG8_SCHED;
            PG8_STAGE(PG8_SB(1, 1), b3 + hstep, voffB);
            PG8_WAIT_V(6); PG8_BAR; PG8_MMA(1, 1, At, B1); PG8_BAR;
            }
        }
        if constexpr (ALIGN_EPI) { if (wr == 0) PG8_BAR; }
        if constexpr (!Epi::AFTER_DRAIN) { E(acc, cur, wr, wc, fr, fq); S.done(cur); }
        if (!has_next) break;
#pragma unroll
        for (int a = 0; a < 2; ++a)
#pragma unroll
            for (int b = 0; b < 2; ++b)
#pragma unroll
                for (int m = 0; m < 4; ++m)
#pragma unroll
                    for (int n = 0; n < 2; ++n) acc[a][b][m][n] = (f32x4){0.f, 0.f, 0.f, 0.f};
        cur = nxt; cA = nA; cB = nB; ++ui;
        if constexpr (ALIGN_EPI) { if (wr == 1) PG8_BAR; }
    }
    PG8_WAIT_V(0);
    if constexpr (!ALIGN_EPI) { if (wr == 0) PG8_BAR; }
    PG8_BAR;
    if constexpr (Epi::AFTER_DRAIN) { E.fused(acc, cur, wr, wc, fr, fq, lds, wid, lane); S.done(cur); }
#undef PG8_SA
#undef PG8_SB
#undef PG8_STAGE
#undef PG8_LDA
#undef PG8_LDB
#undef PG8_MMA
#undef PG8_WAIT_V
#undef PG8_WAIT_L
#undef PG8_BAR
#undef PG8_SCHED
}
}

#define LAS __attribute__((address_space(3)))
using namespace pg8;
typedef unsigned u32x2 __attribute__((ext_vector_type(2)));
typedef float f32x16 __attribute__((ext_vector_type(16)));

constexpr int NWAVES = 8, NTHREADS = 512;
constexpr int DM = 1024, MROWS = 16640, RP = 16384, TS = 2048, DIN = 2560, DFF = 2816, NGU = 5632;
constexpr int LDS_BYTES = 139264;
constexpr float LOG2E = 1.4426950408889634f;

constexpr size_t MiB = 1u << 20;
constexpr size_t WS_STAT = 0;
constexpr size_t WS_WQKV = 1 * MiB;
constexpr size_t WS_WO = 7 * MiB;
constexpr size_t WS_WGU = 9 * MiB;
constexpr size_t WS_WD = 21 * MiB;
constexpr size_t WS_XB = 27 * MiB;
constexpr size_t WS_Q = 60 * MiB;
constexpr size_t WS_KP = 77 * MiB;
constexpr size_t WS_KS = 93 * MiB;
constexpr size_t WS_VT = 98 * MiB;
constexpr size_t WS_VTS = 114 * MiB;
constexpr size_t WS_U = 119 * MiB;
constexpr size_t WS_US = 135 * MiB + 512 * 1024;
constexpr size_t WS_OC = 136 * MiB;
constexpr size_t WS_HM = 60 * MiB;
static_assert(WS_HM + (size_t)MROWS * DFF * 2 <= 169 * MiB, "ws map");

struct Args {
    const float *x_prompt, *x_sample, *cache_k, *cache_v, *state_conv, *g_mix, *w_in, *rel_table, *w_dw, *b_dw, *ln_g, *ln_b, *w_out, *g_ffn, *w_gate, *w_up, *w_down, *g_final;
    float* out; unsigned char* ws;
};

__device__ __forceinline__ unsigned cvtpk(float lo, float hi) { unsigned r; asm volatile("v_cvt_pk_bf16_f32 %0, %1, %2" : "=v"(r) : "v"(lo), "v"(hi)); return r; }
__device__ __forceinline__ float wave_sum(float v) {
#pragma unroll
    for (int o = 1; o < 64; o <<= 1) v += __shfl_xor(v, o);
    return v;
}
#define LDS_WAIT() asm volatile("s_waitcnt lgkmcnt(0)" ::: "memory")

__device__ __forceinline__ void transpose_item(const float* W, int ldw, int srccol0, int k0, bf16_t* WT, int ldt, int dstrow0, const float* gs, LAS float* scr, int lane) {
#pragma unroll 8
    for (int i = 0; i < 32; ++i) { const int kk = 2 * i + (lane >> 5); float v = W[(size_t)(k0 + kk) * ldw + srccol0 + (lane & 31)]; if (gs) v *= gs[k0 + kk]; scr[kk * 33 + (lane & 31)] = v; }
    LDS_WAIT(); asm volatile("" ::: "memory");
    const int c = lane & 7;
#pragma unroll
    for (int j = 0; j < 4; ++j) { const int n = (lane >> 3) + 8 * j; const LAS float* s = scr + (8 * c) * 33 + n;
        u32x4 o; o.x = cvtpk(s[0 * 33], s[1 * 33]); o.y = cvtpk(s[2 * 33], s[3 * 33]); o.z = cvtpk(s[4 * 33], s[5 * 33]); o.w = cvtpk(s[6 * 33], s[7 * 33]);
        *(u32x4*)(WT + (size_t)(dstrow0 + n) * ldt + k0 + 8 * c) = o; }
    LDS_WAIT(); asm volatile("" ::: "memory");
}

__device__ __forceinline__ void p0_prologue(const Args& A, LAS unsigned char* lds, int tid, int lane, int wave) {
    unsigned char* ws = A.ws;
    LAS float* scr = (LAS float*)(lds + wave * 16384);
    const int G = gridDim.x, gw = blockIdx.x * NWAVES + wave, NGW = G * NWAVES;
    float* stat = (float*)(ws + WS_STAT);
    for (int i = blockIdx.x * NTHREADS + tid; i < 2 * MROWS; i += G * NTHREADS) stat[MROWS + i] = 0.f;
    constexpr int I_A = 16 * 80, I_B = 16 * 32, I_C = 16 * 176, I_D = 44 * 32, I_E = 8 * 128;
    constexpr int NITEMS = I_A + I_B + I_C + I_D + I_E;
    for (int it = gw; it < NITEMS; it += NGW) {
        int r = it;
        if (r < I_A) { const int kb = r / 80, nb = r % 80, d0 = 32 * nb; int sc = d0;
            if (d0 >= 1536) { const int j = d0 - 1536, t = j >> 8, jj = j & 255; sc = (jj < 128) ? 1536 + 128 * t + jj : 2048 + 128 * t + (jj - 128); }
            transpose_item(A.w_in, DIN, sc, 64 * kb, (bf16_t*)(ws + WS_WQKV), DM, d0, A.g_mix, scr, lane); continue; } r -= I_A;
        if (r < I_B) { const int kb = r / 32, nb = r % 32; transpose_item(A.w_out, DM, 32 * nb, 64 * kb, (bf16_t*)(ws + WS_WO), DM, 32 * nb, nullptr, scr, lane); continue; } r -= I_B;
        if (r < I_C) { const int kb = r / 176, nb = r % 176, d0 = 32 * nb, t = d0 >> 8, jj = d0 & 255;
            transpose_item(jj < 128 ? A.w_gate : A.w_up, DFF, 128 * t + (jj & 127), 64 * kb, (bf16_t*)(ws + WS_WGU), DM, d0, A.g_ffn, scr, lane); continue; } r -= I_C;
        if (r < I_D) { const int kb = r / 32, nb = r % 32; transpose_item(A.w_down, DM, 32 * nb, 64 * kb, (bf16_t*)(ws + WS_WD), DFF, 32 * nb, nullptr, scr, lane); continue; } r -= I_D;
        { const int b = r >> 7, q = r & 127, kb = q >> 4, nb = q & 15;
          transpose_item(A.cache_v + (size_t)b * 512 * 512, 512, 32 * nb, 64 * kb, (bf16_t*)(ws + WS_VTS) + (size_t)b * 512 * 544, 544, 32 * nb, nullptr, scr, lane); }
    }
    bf16_t* XB = (bf16_t*)(ws + WS_XB);
    for (int m = gw; m < MROWS; m += NGW) {
        const float* xr = (m < RP) ? A.x_prompt + (size_t)m * DM : A.x_sample + (size_t)(m - RP) * DM;
        f32x4 v[4]; float s = 0.f;
#pragma unroll
        for (int j = 0; j < 4; ++j) { v[j] = ((const f32x4*)xr)[lane + 64 * j]; s += (v[j].x * v[j].x + v[j].y * v[j].y) + (v[j].z * v[j].z + v[j].w * v[j].w); }
        s = wave_sum(s);
        if (lane == 0) stat[m] = __builtin_amdgcn_rsqf(s * (1.0f / DM) + 1e-6f);
        u32x2* o = (u32x2*)(XB + (size_t)m * DM);
#pragma unroll
        for (int j = 0; j < 4; ++j) o[lane + 64 * j] = (u32x2){cvtpk(v[j].x, v[j].y), cvtpk(v[j].z, v[j].w)};
    }
    for (int m = gw; m < 240; m += NGW) { const int b = m / 30, i = m % 30;
        const f32x4 v0 = ((const f32x4*)(A.state_conv + (size_t)m * 512))[lane], v1 = ((const f32x4*)(A.state_conv + (size_t)m * 512))[lane + 64];
        u32x2* o = (u32x2*)((bf16_t*)(ws + WS_US) + ((size_t)b * 62 + i) * 512); o[lane] = (u32x2){cvtpk(v0.x, v0.y), cvtpk(v0.z, v0.w)}; o[lane + 64] = (u32x2){cvtpk(v1.x, v1.y), cvtpk(v1.z, v1.w)}; }
    bf16_t* KS = (bf16_t*)(ws + WS_KS);
    for (int m = gw; m < 2 * 4096; m += NGW) {
        const int isv = m >= 4096, rr = m & 4095, b = rr >> 9, pos = rr & 511;
        const float* src = (isv ? A.cache_v : A.cache_k) + (size_t)rr * 512;
        const f32x4 v0 = ((const f32x4*)src)[lane], v1 = ((const f32x4*)src)[lane + 64];
        if (pos >= 32) { float* o = A.out + (isv ? OFF_VS : OFF_KS) + ((size_t)b * 512 + pos - 32) * 512; ((f32x4*)o)[lane] = v0; ((f32x4*)o)[lane + 64] = v1; }
        if (!isv) { u32x2* o = (u32x2*)(KS + ((size_t)b * 544 + pos) * 512); o[lane] = (u32x2){cvtpk(v0.x, v0.y), cvtpk(v0.z, v0.w)}; o[lane + 64] = (u32x2){cvtpk(v1.x, v1.y), cvtpk(v1.z, v1.w)}; }
    }
}

template <int NQT>
__device__ __forceinline__ void attn_unit(const bf16_t* Qp, const bf16_t* Kb, const bf16_t* VTb, int vtp, int kt0, int kt1, const LAS float* bt, bf16_t* Op, int lane) {
    const int r = lane & 31, h = lane >> 5;
    const int krow = (r & ~12) | ((r & 4) << 1) | ((r & 8) >> 1);
    constexpr float SC = 0.125f * LOG2E;
    bf16x8 qf[NQT][4];
#pragma unroll
    for (int c = 0; c < NQT; ++c)
#pragma unroll
        for (int s = 0; s < 4; ++s) qf[c][s] = *(const bf16x8*)(Qp + (size_t)(32 * c + r) * 512 + 16 * s + 8 * h);
    f32x16 o[2][NQT]; float mrun[NQT], lrun[NQT];
#pragma unroll
    for (int c = 0; c < NQT; ++c) { mrun[c] = -1e30f; lrun[c] = 0.f;
#pragma unroll
        for (int dt = 0; dt < 2; ++dt)
#pragma unroll
            for (int i = 0; i < 16; ++i) o[dt][c][i] = 0.f; }
    const bf16_t* kp = Kb + (long)krow * 512 + 8 * h;
    const bf16_t* vp = VTb + (long)r * vtp + 8 * h;
    bf16x8 kf[4];
#pragma unroll
    for (int s = 0; s < 4; ++s) kf[s] = *(const bf16x8*)(kp + (long)kt0 * 32 * 512 + 16 * s);
    const float cbias = bt[256];
    bf16x8 vf[2][2];
#pragma unroll
    for (int dt = 0; dt < 2; ++dt)
#pragma unroll
        for (int s = 0; s < 2; ++s) vf[dt][s] = *(const bf16x8*)(vp + (long)(32 * dt) * vtp + 32 * kt0 + 16 * s);
    for (int kt = kt0; kt < kt1; ++kt) {
        const int ktn = (kt + 1 < kt1) ? kt + 1 : kt;
        bf16x8 kn[4], vn[2][2];
#pragma unroll
        for (int s = 0; s < 4; ++s) kn[s] = *(const bf16x8*)(kp + (long)ktn * 32 * 512 + 16 * s);
#pragma unroll
        for (int dt = 0; dt < 2; ++dt)
#pragma unroll
            for (int s = 0; s < 2; ++s) vn[dt][s] = *(const bf16x8*)(vp + (long)(32 * dt) * vtp + 32 * ktn + 16 * s);
        f32x16 sa[NQT];
#pragma unroll
        for (int c = 0; c < NQT; ++c) {
#pragma unroll
            for (int i = 0; i < 16; ++i) sa[c][i] = 0.f;
#pragma unroll
            for (int s = 0; s < 4; ++s) sa[c] = __builtin_amdgcn_mfma_f32_32x32x16_bf16(kf[s], qf[c][s], sa[c], 0, 0, 0); }
        bf16x8 pf[NQT][2];
#pragma unroll
        for (int c = 0; c < NQT; ++c) {
            if (kt <= 11) {
#pragma unroll
                for (int i = 0; i < 16; ++i) sa[c][i] = sa[c][i] * SC + cbias;
            } else {
                const int base = 32 * c + r - 32 * kt - 8 * h + 512;
#pragma unroll
                for (int i = 0; i < 16; ++i) { const int koff = (i & 3) + 4 * ((i >> 2) & 1) + 16 * (i >> 3); int rel = base - koff; rel = rel > 128 ? 128 : rel; sa[c][i] = sa[c][i] * SC + bt[rel + 128]; }
            }
            float mx = sa[c][0];
#pragma unroll
            for (int i = 1; i < 16; ++i) mx = fmaxf(mx, sa[c][i]);
            mx = fmaxf(mx, __shfl_xor(mx, 32));
            const float mnew = fmaxf(mrun[c], mx), alpha = __builtin_amdgcn_exp2f(mrun[c] - mnew);
            mrun[c] = mnew; float ls = 0.f;
#pragma unroll
            for (int i = 0; i < 16; ++i) { sa[c][i] = __builtin_amdgcn_exp2f(sa[c][i] - mnew); ls += sa[c][i]; }
            lrun[c] = lrun[c] * alpha + ls;
#pragma unroll
            for (int dt = 0; dt < 2; ++dt)
#pragma unroll
                for (int i = 0; i < 16; ++i) o[dt][c][i] *= alpha;
#pragma unroll
            for (int s = 0; s < 2; ++s) { u32x4 w; w.x = cvtpk(sa[c][8 * s + 0], sa[c][8 * s + 1]); w.y = cvtpk(sa[c][8 * s + 2], sa[c][8 * s + 3]); w.z = cvtpk(sa[c][8 * s + 4], sa[c][8 * s + 5]); w.w = cvtpk(sa[c][8 * s + 6], sa[c][8 * s + 7]);
                pf[c][s] = __builtin_bit_cast(bf16x8, w); }
        }
#pragma unroll
        for (int dt = 0; dt < 2; ++dt)
#pragma unroll
            for (int c = 0; c < NQT; ++c)
#pragma unroll
                for (int s = 0; s < 2; ++s) o[dt][c] = __builtin_amdgcn_mfma_f32_32x32x16_bf16(vf[dt][s], pf[c][s], o[dt][c], 0, 0, 0);
#pragma unroll
        for (int s = 0; s < 4; ++s) kf[s] = kn[s];
#pragma unroll
        for (int dt = 0; dt < 2; ++dt)
#pragma unroll
            for (int s = 0; s < 2; ++s) vf[dt][s] = vn[dt][s];
    }
#pragma unroll
    for (int c = 0; c < NQT; ++c) { const float l = lrun[c] + __shfl_xor(lrun[c], 32); const float inv = 1.0f / l;
#pragma unroll
        for (int dt = 0; dt < 2; ++dt)
#pragma unroll
            for (int g = 0; g < 4; ++g) { const int d = 32 * dt + 8 * g + 4 * h;
                *(u32x2*)(Op + (size_t)(32 * c + r) * 1024 + d) = (u32x2){cvtpk(o[dt][c][4 * g] * inv, o[dt][c][4 * g + 1] * inv), cvtpk(o[dt][c][4 * g + 2] * inv, o[dt][c][4 * g + 3] * inv)}; } }
}

__device__ __forceinline__ float bf_lo(unsigned w) { return __builtin_bit_cast(float, w << 16); }
__device__ __forceinline__ float bf_hi(unsigned w) { return __builtin_bit_cast(float, w & 0xffff0000u); }

__device__ __forceinline__ void conv_unit(const Args& A, const bf16_t* ub, int tmin, int t0, bf16_t* ob, LAS float* red, int tid, int lane, int wave) {
    const int tg = tid >> 8, cp = tid & 255, c = 2 * cp, tb = t0 + 8 * tg;
    unsigned uw[38];
#pragma unroll
    for (int i = 0; i < 38; ++i) { const int t = tb - 30 + i; const int tc = t < tmin ? tmin : t; uw[i] = *(const unsigned*)(ub + (long)tc * 512 + c); }
    f32x2 wv[31];
#pragma unroll
    for (int j = 0; j < 31; ++j) wv[j] = *(const f32x2*)(A.w_dw + (size_t)j * 512 + c);
    const f32x2 bd = *(const f32x2*)(A.b_dw + c);
    f32x2 in[38];
#pragma unroll
    for (int i = 0; i < 38; ++i) { const int t = tb - 30 + i; float a0 = bf_lo(uw[i]), a1 = bf_hi(uw[i]);
        if (i < 30) { a0 = t < tmin ? 0.f : a0; a1 = t < tmin ? 0.f : a1; }
        in[i] = (f32x2){a0, a1}; }
    f32x2 y[8];
#pragma unroll
    for (int k = 0; k < 8; ++k) y[k] = bd;
#pragma unroll
    for (int j = 0; j < 31; ++j) {
#pragma unroll
        for (int k = 0; k < 8; ++k) y[k] += wv[j] * in[k + j]; }
    float s1[8], s2[8];
#pragma unroll
    for (int k = 0; k < 8; ++k) { s1[k] = wave_sum(y[k].x + y[k].y); s2[k] = wave_sum(y[k].x * y[k].x + y[k].y * y[k].y); }
    if (lane == 0) {
#pragma unroll
        for (int k = 0; k < 8; ++k) { red[wave * 16 + k] = s1[k]; red[wave * 16 + 8 + k] = s2[k]; } }
    __syncthreads();
    const f32x2 lg = *(const f32x2*)(A.ln_g + c), lb = *(const f32x2*)(A.ln_b + c);
#pragma unroll
    for (int k = 0; k < 8; ++k) {
        float S1 = 0.f, S2 = 0.f;
#pragma unroll
        for (int w = 0; w < 4; ++w) { S1 += red[(4 * tg + w) * 16 + k]; S2 += red[(4 * tg + w) * 16 + 8 + k]; }
        const float mean = S1 * (1.0f / 512.0f), var = S2 * (1.0f / 512.0f) - mean * mean, rstd = __builtin_amdgcn_rsqf(var + 1e-5f);
        const float z0 = (y[k].x - mean) * rstd * lg.x + lb.x, z1 = (y[k].y - mean) * rstd * lg.y + lb.y;
        const float o0 = z0 * fast_sigmoid(z0), o1 = z1 * fast_sigmoid(z1);
        *(unsigned*)(ob + (size_t)(tb + k) * 1024 + c) = cvtpk(o0, o1);
    }
    __syncthreads();
}

#ifndef REP_P0
#define REP_P0 1
#endif
#ifndef REP_ATT
#define REP_ATT 1
#endif
#ifndef REP_CONV
#define REP_CONV 1
#endif
#ifndef REP_P1
#define REP_P1 1
#endif
#ifndef REP_P2
#define REP_P2 1
#endif
#ifndef REP_P4
#define REP_P4 1
#endif
__global__ void __launch_bounds__(NTHREADS, 2) fwd_megakernel(Args A) {
    extern __shared__ __attribute__((aligned(16))) unsigned char lds_raw[];
    cg::grid_group grid = cg::this_grid();
    LAS unsigned char* lds = (LAS unsigned char*)lds_raw;
#define FRESH_TID() int tid_ = threadIdx.x; asm volatile("" : "+v"(tid_)); const int tid = tid_, lane = tid & 63, wave = __builtin_amdgcn_readfirstlane(tid >> 6); (void)lane; (void)wave;
    const int G = gridDim.x;
    unsigned char* ws = A.ws;
    float* stat = (float*)(ws + WS_STAT);
    bf16_t* XB = (bf16_t*)(ws + WS_XB);

    for (int rep = 0; rep < REP_P0; ++rep) { FRESH_TID(); p0_prologue(A, lds, tid, lane, wave); }
    grid.sync();

    for (int rep = 0; rep < REP_P1; ++rep) {
        pg8::Gemm g{XB, (const bf16_t*)(ws + WS_WQKV), MROWS, DIN, DM}; pg8::StaticOrder S; S.init(MROWS, DIN, G, (int)blockIdx.x);
        pg8::EpiQKV E{stat, (bf16_t*)(ws + WS_Q), (bf16_t*)(ws + WS_KP), (bf16_t*)(ws + WS_KS), (bf16_t*)(ws + WS_VT), (bf16_t*)(ws + WS_VTS), (bf16_t*)(ws + WS_U), (bf16_t*)(ws + WS_US), A.out};
        pg8::gemm_phase<pg8::EpiQKV, pg8::StaticOrder, true, true>(lds, g, S, E);
    }
    grid.sync();

    for (int rep = 0; rep < REP_P2; ++rep) {
        FRESH_TID();
        LAS float* bt = (LAS float*)lds; LAS float* red = (LAS float*)(lds + 16384);
        for (int i = tid; i < 8 * 257; i += NTHREADS) bt[i] = A.rel_table[i] * LOG2E;
        __syncthreads();
        const bf16_t* Q = (const bf16_t*)(ws + WS_Q); const bf16_t* KP = (const bf16_t*)(ws + WS_KP); const bf16_t* KS = (const bf16_t*)(ws + WS_KS);
        const bf16_t* VT = (const bf16_t*)(ws + WS_VT); const bf16_t* VTS = (const bf16_t*)(ws + WS_VTS); bf16_t* OC = (bf16_t*)(ws + WS_OC);
        for (int rep2 = 0; rep2 < REP_ATT; ++rep2)
        for (int pc = blockIdx.x; pc < 256; pc += G) {
            const int b = pc >> 5, c = pc & 31, hd = wave;
            const long row0 = (long)b * TS + 64 * c;
            attn_unit<2>(Q + row0 * 512 + hd * 64, KP + (row0 - 512) * 512 + hd * 64, VT + ((long)b * 512 + hd * 64) * TS + 64 * c - 512, TS, (16 - 2 * c) > 0 ? (16 - 2 * c) : 0, 18,
                         bt + hd * 257, OC + row0 * 1024 + hd * 64, lane);
            if (c == 0) { const long rs = RP + b * 32; int lane2 = threadIdx.x & 63; asm volatile("" : "+v"(lane2)); const int lane = lane2;
                attn_unit<1>(Q + rs * 512 + hd * 64, KS + (long)b * 544 * 512 + hd * 64, VTS + ((long)b * 512 + hd * 64) * 544, 544, 0, 17, bt + hd * 257, OC + rs * 1024 + hd * 64, lane); }
        }
        __syncthreads();
        int tid2 = threadIdx.x; asm volatile("" : "+v"(tid2));
        for (int rep2 = 0; rep2 < REP_CONV; ++rep2)
        for (int u = blockIdx.x; u < 1040; u += G) {
            const int tid = tid2, lane = tid2 & 63;
            const bool smp = u >= 1024; const int b = smp ? (u - 1024) >> 1 : u >> 7, t0 = smp ? ((u - 1024) & 1) * 16 : (u & 127) * 16;
            const bf16_t* ub = smp ? (const bf16_t*)(ws + WS_US) + ((size_t)b * 62 + 30) * 512 : (const bf16_t*)(ws + WS_U) + (size_t)b * TS * 512;
            conv_unit(A, ub, smp ? -30 : 0, t0, OC + (size_t)(smp ? RP + b * 32 : b * TS) * 1024 + 512, red, tid, lane, wave);
        }
    }
    grid.sync();

    {
        pg8::Gemm g{(const bf16_t*)(ws + WS_OC), (const bf16_t*)(ws + WS_WO), MROWS, DM, DM}; pg8::StaticOrder S; S.init(MROWS, DM, G, (int)blockIdx.x);
        pg8::EpiRes<true> E{A.x_prompt, A.x_sample, A.out, XB, stat + MROWS};
        pg8::gemm_phase<pg8::EpiRes<true>, pg8::StaticOrder, true, true>(lds, g, S, E);
    }
    grid.sync();

    for (int rep = 0; rep < REP_P4; ++rep) {
        pg8::Gemm g{XB, (const bf16_t*)(ws + WS_WGU), MROWS, NGU, DM}; pg8::StaticOrder S; S.init(MROWS, NGU, G, (int)blockIdx.x);
        pg8::EpiGU E{stat + MROWS, (bf16_t*)(ws + WS_HM)};
        pg8::gemm_phase<pg8::EpiGU, pg8::StaticOrder, true, true>(lds, g, S, E);
    }
    grid.sync();

    {
        pg8::Gemm g{(const bf16_t*)(ws + WS_HM), (const bf16_t*)(ws + WS_WD), MROWS, DM, DFF}; pg8::StaticOrder S; S.init(MROWS, DM, G, (int)blockIdx.x);
        pg8::EpiRes<false> E{A.out, A.out + (size_t)RP * DM, A.out, nullptr, stat + 2 * MROWS};
        pg8::gemm_phase<pg8::EpiRes<false>, pg8::StaticOrder, true, true>(lds, g, S, E);
    }
    grid.sync();

    {
        FRESH_TID();
        const int gw = blockIdx.x * NWAVES + wave, NGW = G * NWAVES;
        f32x4 gf[4];
#pragma unroll
        for (int j = 0; j < 4; ++j) gf[j] = ((const f32x4*)A.g_final)[lane + 64 * j];
        for (int m = gw; m < MROWS; m += NGW) {
            f32x4* row = (f32x4*)(A.out + (size_t)m * DM);
            const float rs = __builtin_amdgcn_rsqf(stat[2 * MROWS + m] * (1.0f / DM) + 1e-6f);
#pragma unroll
            for (int j = 0; j < 4; ++j) row[lane + 64 * j] = row[lane + 64 * j] * rs * gf[j];
        }
    }
}

extern "C" void kernel_launch(void* const* d_in, const int* in_sizes, int n_in, void* d_out, int out_size, void* d_ws, size_t ws_size, hipStream_t stream) {
    static int grid = 0;
    if (grid == 0) {
        int dev = 0, cus = 0, per_cu = 0;
        hipGetDevice(&dev);
        hipDeviceGetAttribute(&cus, hipDeviceAttributeMultiprocessorCount, dev);
        if (hipFuncSetAttribute((const void*)fwd_megakernel, hipFuncAttributeMaxDynamicSharedMemorySize, LDS_BYTES) != hipSuccess) { fprintf(stderr, "hipFuncSetAttribute failed\n"); }
        hipOccupancyMaxActiveBlocksPerMultiprocessor(&per_cu, (const void*)fwd_megakernel, NTHREADS, LDS_BYTES);
        (void)hipGetLastError();
        if (per_cu < 1) per_cu = 1;
        grid = cus * per_cu;
    }
    Args a{};
    a.x_prompt = (const float*)d_in[0]; a.x_sample = (const float*)d_in[1]; a.cache_k = (const float*)d_in[2]; a.cache_v = (const float*)d_in[3]; a.state_conv = (const float*)d_in[4];
    a.g_mix = (const float*)d_in[5]; a.w_in = (const float*)d_in[6]; a.rel_table = (const float*)d_in[7]; a.w_dw = (const float*)d_in[8]; a.b_dw = (const float*)d_in[9];
    a.ln_g = (const float*)d_in[10]; a.ln_b = (const float*)d_in[11]; a.w_out = (const float*)d_in[12]; a.g_ffn = (const float*)d_in[13]; a.w_gate = (const float*)d_in[14];
    a.w_up = (const float*)d_in[15]; a.w_down = (const float*)d_in[16]; a.g_final = (const float*)d_in[17];
    a.out = (float*)d_out; a.ws = (unsigned char*)d_ws;
    void* args[] = {&a};
    hipError_t e = hipLaunchCooperativeKernel((const void*)fwd_megakernel, dim3(grid), dim3(NTHREADS), args, LDS_BYTES, stream);
    if (e != hipSuccess) fprintf(stderr, "cooperative launch failed: %s (grid %d)\n", hipGetErrorString(e), grid);
}
```

```cpp
#include <hip/hip_runtime.h>
#include <hip/hip_cooperative_groups.h>
#include <cstdio>
#include <cstdint>
namespace cg = cooperative_groups;
namespace pg8 {
#define PG8_LAS __attribute__((address_space(3)))
typedef unsigned short bf16_t;
typedef short bf16x8 __attribute__((ext_vector_type(8)));
typedef float f32x4 __attribute__((ext_vector_type(4)));
typedef unsigned u32x4 __attribute__((ext_vector_type(4)));
constexpr int BM = 256, BK = 64, HALF = 128, HTB = HALF * BK * 2  , STAGE_BYTES = 8 * HTB, NXCD = 8, WGM = 8;

__host__ __device__ __forceinline__ int lds_byte(int r, int c) { const int st = (r >> 4) * 2 + (c >> 5), rr = r & 15, cc = c & 31, ob = rr * 64 + cc * 2; return st * 1024 + (ob ^ (((ob >> 9) & 1) << 5)); }
__host__ __device__ __forceinline__ void stage_rc(int b, int& R, int& C) { const int st = b / 1024, sb = b % 1024, swz = sb ^ (((sb >> 9) & 1) << 5); R = (st >> 1) * 16 + swz / 64; C = (st & 1) * 32 + (swz % 64) / 2; }
__host__ __device__ __forceinline__ int perm32(int rho) { const int n = rho >> 4, i = rho & 15; return 8 * (i >> 2) + 4 * n + (i & 3); }

struct Unit { int pm, pn; };
struct Gemm { const bf16_t* A; const bf16_t* Bt; int M, N, K; };

struct StaticOrder {
    int nM, nN, nwg, G, c;
    __host__ __device__ void init(int M, int N, int G_, int c_) { nM = M / BM; nN = N / BM; nwg = nM * nN; G = G_; c = c_; }
    __host__ __device__ bool next(int i, Unit& u) const {
        const long L = (long)i * G + c; if (L >= nwg) return false;
        int wgid = (int)L; { const int q = nwg / NXCD, r = nwg % NXCD, xcd = wgid % NXCD, off = wgid / NXCD; wgid = (xcd < r ? xcd * (q + 1) : r * (q + 1) + (xcd - r) * q) + off; }
        const int nig = WGM * nN, gid = wgid / nig, fm = gid * WGM, gsz = (nM - fm) < WGM ? (nM - fm) : WGM;
        u.pm = fm + ((wgid % nig) % gsz); u.pn = (wgid % nig) / gsz; return true;
    }
    __device__ __forceinline__ void a_ready(const Unit&) const {}
    __device__ __forceinline__ void done(const Unit&) const {}
};

__device__ __forceinline__ unsigned cvt_pk_bf16(float lo, float hi) { unsigned r; asm volatile("v_cvt_pk_bf16_f32 %0, %1, %2" : "=v"(r) : "v"(lo), "v"(hi)); return r; }
typedef float f32x2 __attribute__((ext_vector_type(2)));

constexpr int R_PROMPT = 16384, T_SEQ = 2048;
constexpr size_t OFF_Y = 0, OFF_KP = 17039360, OFF_VP = 19136512, OFF_CP = 21233664, OFF_KS = 21356544, OFF_VS = 23453696, OFF_CS = 25550848;

__device__ __forceinline__ u32x4 pack8(const f32x4 a, const f32x4 b) { u32x4 w; w.x = cvt_pk_bf16(a[0], a[1]); w.y = cvt_pk_bf16(a[2], a[3]); w.z = cvt_pk_bf16(b[0], b[1]); w.w = cvt_pk_bf16(b[2], b[3]); return w; }
__device__ __forceinline__ float fast_sigmoid(float g) { return __builtin_amdgcn_rcpf(1.0f + __builtin_amdgcn_exp2f(-1.4426950408889634f * g)); }

struct EpiQKV {
    static constexpr bool PERM = true, AFTER_DRAIN = false;
    const float* rstd0; bf16_t* Q; bf16_t* KP; bf16_t* KS; bf16_t* VT; bf16_t* VTS; bf16_t* U; bf16_t* US; float* out;
    __device__ __forceinline__ void operator()(const f32x4 (&acc)[2][2][4][2], const Unit& u, int wr, int wc, int fr, int fq) const {
        asm volatile("" : "+v"(fr), "+v"(fq));
        const int rbase = u.pm * BM + wr * 64 + fr;
        const bool sample = (u.pm == 64);
        const int kind = u.pn >> 1;
        const int b = sample ? 0 : (u.pm >> 3);
        if (kind == 0) {
            const int col0 = u.pn * BM + wc * 32 + 8 * fq;
#pragma unroll
            for (int ai = 0; ai < 2; ++ai)
#pragma unroll
                for (int m = 0; m < 4; ++m) { const int r = rbase + ai * HALF + m * 16; const float rs = rstd0[r];
#pragma unroll
                    for (int bj = 0; bj < 2; ++bj) *(u32x4*)(Q + (size_t)r * 512 + col0 + bj * HALF) = pack8(acc[ai][bj][m][0] * rs, acc[ai][bj][m][1] * rs); }
        } else if (kind == 1 || kind == 2) {
            const int col0 = (u.pn & 1) * BM + wc * 32 + 8 * fq;
            const bool isv = (kind == 2);
            const bool keep = sample || ((u.pm & 7) >= 6);
            float* ofp = out + (sample ? (isv ? OFF_VS : OFF_KS) : (isv ? OFF_VP : OFF_KP));
#pragma unroll
            for (int ai = 0; ai < 2; ++ai)
#pragma unroll
                for (int m = 0; m < 4; ++m) { const int r = rbase + ai * HALF + m * 16; const float rs = rstd0[r];
                    int sb, st, orow;
                    if (sample) { const int rr = r - R_PROMPT; sb = rr >> 5; st = 512 + (rr & 31); orow = sb * 512 + 480 + (rr & 31); }
                    else { sb = b; st = r - b * T_SEQ; orow = b * 512 + st - 1536; }
#pragma unroll
                    for (int bj = 0; bj < 2; ++bj) { const f32x4 v0 = acc[ai][bj][m][0] * rs, v1 = acc[ai][bj][m][1] * rs; const int c = col0 + bj * HALF;
                        if (keep) { *(f32x4*)(ofp + (size_t)orow * 512 + c) = v0; *(f32x4*)(ofp + (size_t)orow * 512 + c + 4) = v1; }
                        const u32x4 w = pack8(v0, v1);
                        if (!isv) { bf16_t* kd = sample ? KS + ((size_t)sb * 544 + st) * 512 : KP + (size_t)r * 512; *(u32x4*)(kd + c) = w; }
                        else { bf16_t* vd = sample ? VTS + ((size_t)sb * 512 + c) * 544 + st : VT + ((size_t)sb * 512 + c) * T_SEQ + st; const int vp = sample ? 544 : T_SEQ;
                            vd[0] = (bf16_t)(w.x & 0xffffu); vd[vp] = (bf16_t)(w.x >> 16); vd[2 * vp] = (bf16_t)(w.y & 0xffffu); vd[3 * vp] = (bf16_t)(w.y >> 16);
                            vd[4 * vp] = (bf16_t)(w.z & 0xffffu); vd[5 * vp] = (bf16_t)(w.z >> 16); vd[6 * vp] = (bf16_t)(w.w & 0xffffu); vd[7 * vp] = (bf16_t)(w.w >> 16); } } }
        } else {
            const int ch0 = (u.pn - 6) * HALF + wc * 32 + 8 * fq;
            const bool tail = sample || ((u.pm & 7) == 7);
#pragma unroll
            for (int ai = 0; ai < 2; ++ai)
#pragma unroll
                for (int m = 0; m < 4; ++m) { const int r = rbase + ai * HALF + m * 16; const float rs = rstd0[r];
                    f32x4 v[2];
#pragma unroll
                    for (int n = 0; n < 2; ++n) { const f32x4 a = acc[ai][0][m][n] * rs, g = acc[ai][1][m][n] * rs;
                        v[n] = (f32x4){a[0] * fast_sigmoid(g[0]), a[1] * fast_sigmoid(g[1]), a[2] * fast_sigmoid(g[2]), a[3] * fast_sigmoid(g[3])}; }
                    { bf16_t* ud = sample ? US + ((size_t)((r - R_PROMPT) >> 5) * 62 + 30 + ((r - R_PROMPT) & 31)) * 512 : U + (size_t)r * 512; *(u32x4*)(ud + ch0) = pack8(v[0], v[1]); }
                    if (tail) { int orow = -1;
                        if (sample) { const int rr = r - R_PROMPT; if ((rr & 31) >= 2) orow = (rr >> 5) * 30 + (rr & 31) - 2; }
                        else { const int st = r - b * T_SEQ; if (st >= T_SEQ - 30) orow = b * 30 + st - (T_SEQ - 30); }
                        if (orow >= 0) { float* o = out + (sample ? OFF_CS : OFF_CP) + (size_t)orow * 512 + ch0; *(f32x4*)o = v[0]; *(f32x4*)(o + 4) = v[1]; } } }
        }
    }
};

template <bool BF> struct EpiRes {
    static constexpr bool PERM = true, AFTER_DRAIN = false;
    const float* basep; const float* bases; float* outf; bf16_t* outb; float* ss;
    __device__ __forceinline__ void operator()(const f32x4 (&acc)[2][2][4][2], const Unit& u, int wr, int wc, int fr, int fq) const {
        asm volatile("" : "+v"(fr), "+v"(fq));
        const int rbase = u.pm * BM + wr * 64 + fr; const int col0 = u.pn * BM + wc * 32 + 8 * fq;
        const float* bp = (u.pm == 64) ? bases - (size_t)R_PROMPT * 1024 : basep;
#pragma unroll
        for (int ai = 0; ai < 2; ++ai)
#pragma unroll
            for (int m = 0; m < 4; ++m) { const int r = rbase + ai * HALF + m * 16; const size_t off = (size_t)r * 1024 + col0; float s = 0.f;
#pragma unroll
                for (int bj = 0; bj < 2; ++bj) { const f32x4 xa = *(const f32x4*)(bp + off + bj * HALF), xb = *(const f32x4*)(bp + off + bj * HALF + 4);
                    const f32x4 v0 = acc[ai][bj][m][0] + xa, v1 = acc[ai][bj][m][1] + xb;
                    *(f32x4*)(outf + off + bj * HALF) = v0; *(f32x4*)(outf + off + bj * HALF + 4) = v1;
                    if (BF) *(u32x4*)(outb + off + bj * HALF) = pack8(v0, v1);
                    s += (v0[0] * v0[0] + v0[1] * v0[1]) + (v0[2] * v0[2] + v0[3] * v0[3]) + (v1[0] * v1[0] + v1[1] * v1[1]) + (v1[2] * v1[2] + v1[3] * v1[3]); }
                s += __shfl_xor(s, 16); s += __shfl_xor(s, 32);
                if (fq == 0) (void)__hip_atomic_fetch_add(ss + r, s, __ATOMIC_RELAXED, __HIP_MEMORY_SCOPE_AGENT); }
    }
};

struct EpiGU {
    static constexpr bool PERM = true, AFTER_DRAIN = false;
    const float* ss1; bf16_t* HM;
    __device__ __forceinline__ void operator()(const f32x4 (&acc)[2][2][4][2], const Unit& u, int wr, int wc, int fr, int fq) const {
        asm volatile("" : "+v"(fr), "+v"(fq));
        const int rbase = u.pm * BM + wr * 64 + fr; const int ch0 = u.pn * HALF + wc * 32 + 8 * fq;
#pragma unroll
        for (int ai = 0; ai < 2; ++ai)
#pragma unroll
            for (int m = 0; m < 4; ++m) { const int r = rbase + ai * HALF + m * 16; const float rs = __builtin_amdgcn_rsqf(ss1[r] * (1.0f / 1024.0f) + 1e-6f);
                f32x4 v[2];
#pragma unroll
                for (int n = 0; n < 2; ++n) { const f32x4 g = acc[ai][0][m][n] * rs, up = acc[ai][1][m][n] * rs;
                    v[n] = (f32x4){g[0] * fast_sigmoid(g[0]) * up[0], g[1] * fast_sigmoid(g[1]) * up[1], g[2] * fast_sigmoid(g[2]) * up[2], g[3] * fast_sigmoid(g[3]) * up[3]}; }
                *(u32x4*)(HM + (size_t)r * 2816 + ch0) = pack8(v[0], v[1]); }
    }
};
template <class Epi, class Sched, bool ALIGN_EPI = false, bool SP2 = false>
__device__ __forceinline__ void gemm_phase(PG8_LAS unsigned char* lds, const Gemm g, const Sched& S, const Epi& E) {
    int tid_ = threadIdx.x; asm volatile("" : "+v"(tid_)); const int tid = tid_, wid = __builtin_amdgcn_readfirstlane(tid >> 6), lane = tid & 63, wr = wid >> 2, wc = wid & 3, fr = lane & 15, fq = lane >> 4;
    const int K = g.K, nt = K / BK;
    unsigned voffA[2], voffB[2];
#pragma unroll
    for (int i = 0; i < 2; ++i) { int R, C; stage_rc(tid * 16 + i * 8192, R, C); const int Rb = Epi::PERM ? ((R & ~31) + perm32(R & 31)) : R;
        voffA[i] = (unsigned)(R * K + C) * 2u; voffB[i] = (unsigned)(Rb * K + C) * 2u; }
    const size_t kstep = (size_t)(BK * 2);
    const size_t hstep = (size_t)HALF * K * 2;
    const size_t tstep = 2 * hstep;
    const unsigned ldsw = (unsigned)wid * 1024u;
    const int aoff = lds_byte(wr * 64 + fr, fq * 8), boff = lds_byte(wc * 32 + fr, fq * 8);
#define PG8_SA(b, h) (((b) * 2 + (h)) * HTB)
#define PG8_SB(b, h) ((4 + (b) * 2 + (h)) * HTB)
#define PG8_STAGE(bufoff, gbase, voff) do { _Pragma("unroll") for (int _i = 0; _i < 2; ++_i) \
        __builtin_amdgcn_global_load_lds((const unsigned*)((const char*)(gbase) + (voff)[_i]), (PG8_LAS unsigned*)(lds + (bufoff) + ldsw + _i * 8192), 16, 0, 0); } while (0)
#define PG8_LDA(dst, b, h) do { _Pragma("unroll") for (int m = 0; m < 4; ++m) _Pragma("unroll") for (int k = 0; k < 2; ++k) dst[m][k] = *(const PG8_LAS bf16x8*)(lds + PG8_SA(b, h) + aoff + m * 2048 + k * 1024); } while (0)
#define PG8_LDB(dst, b, h) do { _Pragma("unroll") for (int n = 0; n < 2; ++n) _Pragma("unroll") for (int k = 0; k < 2; ++k) dst[n][k] = *(const PG8_LAS bf16x8*)(lds + PG8_SB(b, h) + boff + n * 2048 + k * 1024); } while (0)
#define PG8_MMA(ai, bj, At, Bt) do { __builtin_amdgcn_s_setprio(1); _Pragma("unroll") for (int m = 0; m < 4; ++m) _Pragma("unroll") for (int n = 0; n < 2; ++n) _Pragma("unroll") for (int k = 0; k < 2; ++k) \
        acc[ai][bj][m][n] = __builtin_amdgcn_mfma_f32_16x16x32_bf16(Bt[n][k], At[m][k], acc[ai][bj][m][n], 0, 0, 0); __builtin_amdgcn_s_setprio(0); } while (0)
#define PG8_WAIT_V(n) asm volatile("s_waitcnt vmcnt(" #n ")" ::: "memory")
#define PG8_WAIT_L(n) asm volatile("s_waitcnt lgkmcnt(" #n ")" ::: "memory")
#define PG8_BAR __builtin_amdgcn_s_barrier()
#define PG8_SCHED __builtin_amdgcn_sched_barrier(0)
    Unit cur, nxt; int ui = 0;
    if (!S.next(0, cur)) return;
    f32x4 acc[2][2][4][2];
#pragma unroll
    for (int a = 0; a < 2; ++a)
#pragma unroll
        for (int b = 0; b < 2; ++b)
#pragma unroll
            for (int m = 0; m < 4; ++m)
#pragma unroll
                for (int n = 0; n < 2; ++n) acc[a][b][m][n] = (f32x4){0.f, 0.f, 0.f, 0.f};
    bf16x8 At[4][2], B0[2][2], B1[2][2];
    const char* cA = (const char*)g.A + (size_t)cur.pm * tstep; const char* cB = (const char*)g.Bt + (size_t)cur.pn * tstep;
    S.a_ready(cur);
    if constexpr (SP2) {
        PG8_STAGE(PG8_SB(0, 0), cB, voffB); PG8_STAGE(PG8_SB(0, 1), cB + hstep, voffB); PG8_STAGE(PG8_SA(0, 0), cA, voffA); PG8_STAGE(PG8_SA(0, 1), cA + hstep, voffA);
        if (wr == 1) PG8_BAR;
        PG8_WAIT_V(2); PG8_BAR;
        PG8_STAGE(PG8_SB(1, 0), cB + kstep, voffB); PG8_STAGE(PG8_SA(1, 0), cA + kstep, voffA); PG8_STAGE(PG8_SB(1, 1), cB + hstep + kstep, voffB);
        PG8_WAIT_V(6); PG8_BAR;
    } else {
        PG8_STAGE(PG8_SB(0, 0), cB, voffB); PG8_STAGE(PG8_SA(0, 0), cA, voffA); PG8_STAGE(PG8_SB(0, 1), cB + hstep, voffB); PG8_STAGE(PG8_SA(0, 1), cA + hstep, voffA);
        if (wr == 1) PG8_BAR;
        PG8_WAIT_V(4); PG8_BAR;
        PG8_STAGE(PG8_SB(1, 0), cB + kstep, voffB); PG8_STAGE(PG8_SA(1, 0), cA + kstep, voffA); PG8_STAGE(PG8_SB(1, 1), cB + hstep + kstep, voffB);
        PG8_WAIT_V(6); PG8_BAR;
    }
    for (;;) {
        const bool has_next = S.next(ui + 1, nxt);
        const char* nA = has_next ? (const char*)g.A + (size_t)nxt.pm * tstep : cA; const char* nB = has_next ? (const char*)g.Bt + (size_t)nxt.pn * tstep : cB;
        for (int t = 0; t < nt; t += 2) {
            const bool last = (t == nt - 2);
            const char* a1 = cA + (size_t)(t + 1) * kstep;
            const char* a2 = last ? nA : cA + (size_t)(t + 2) * kstep; const char* b2 = last ? nB : cB + (size_t)(t + 2) * kstep;
            const char* a3 = a2 + kstep; const char* b3 = b2 + kstep;
            if (last && has_next) S.a_ready(nxt);
            if constexpr (SP2) {
            PG8_LDB(B0, 0, 0); PG8_LDB(B1, 0, 1); PG8_SCHED; PG8_LDA(At, 0, 0); PG8_STAGE(PG8_SA(1, 1), a1 + hstep, voffA);
            PG8_WAIT_V(8); PG8_WAIT_L(0); PG8_BAR; PG8_MMA(0, 0, At, B0); PG8_MMA(0, 1, At, B1); PG8_BAR; PG8_SCHED;
            PG8_LDA(At, 0, 1); PG8_STAGE(PG8_SB(0, 0), b2, voffB); PG8_STAGE(PG8_SB(0, 1), b2 + hstep, voffB); PG8_STAGE(PG8_SA(0, 0), a2, voffA);
            PG8_WAIT_V(8); PG8_WAIT_L(0); PG8_BAR; PG8_MMA(1, 0, At, B0); PG8_MMA(1, 1, At, B1); PG8_BAR; PG8_SCHED;
            PG8_LDB(B0, 1, 0); PG8_LDB(B1, 1, 1); PG8_SCHED; PG8_LDA(At, 1, 0); PG8_STAGE(PG8_SA(0, 1), a2 + hstep, voffA);
            PG8_WAIT_V(8); PG8_WAIT_L(0); PG8_BAR; PG8_MMA(0, 0, At, B0); PG8_MMA(0, 1, At, B1); PG8_BAR; PG8_SCHED;
            PG8_LDA(At, 1, 1); PG8_STAGE(PG8_SB(1, 0), b3, voffB); PG8_STAGE(PG8_SB(1, 1), b3 + hstep, voffB); PG8_STAGE(PG8_SA(1, 0), a3, voffA);
            PG8_WAIT_V(8); PG8_WAIT_L(0); PG8_BAR; PG8_MMA(1, 0, At, B0); PG8_MMA(1, 1, At, B1); PG8_BAR; PG8_SCHED;
            } else {
            PG8_LDB(B0, 0, 0); PG8_SCHED; PG8_LDA(At, 0, 0); PG8_STAGE(PG8_SA(1, 1), a1 + hstep, voffA);
            PG8_WAIT_L(8); PG8_BAR; PG8_WAIT_L(0); PG8_MMA(0, 0, At, B0); PG8_BAR; PG8_SCHED;
            PG8_LDB(B1, 0, 1); PG8_STAGE(PG8_SB(0, 0), b2, voffB);
            PG8_BAR; PG8_WAIT_L(0); PG8_MMA(0, 1, At, B1); PG8_BAR;
            PG8_LDA(At, 0, 1); PG8_STAGE(PG8_SA(0, 0), a2, voffA);
            PG8_BAR; PG8_WAIT_L(0); PG8_MMA(1, 0, At, B0); PG8_BAR; PG8_SCHED;
            PG8_STAGE(PG8_SB(0, 1), b2 + hstep, voffB);
            PG8_WAIT_V(6); PG8_BAR; PG8_MMA(1, 1, At, B1); PG8_BAR;
            PG8_LDB(B0, 1, 0); PG8_SCHED; PG8_LDA(At, 1, 0); PG8_STAGE(PG8_SA(0, 1), a2 + hstep, voffA);
            PG8_WAIT_L(8); PG8_BAR; PG8_WAIT_L(0); PG8_MMA(0, 0, At, B0); PG8_BAR; PG8_SCHED;
            PG8_LDB(B1, 1, 1); PG8_STAGE(PG8_SB(1, 0), b3, voffB);
            PG8_BAR; PG8_WAIT_L(0); PG8_MMA(0, 1, At, B1); PG8_BAR;
            PG8_LDA(At, 1, 1); PG8_STAGE(PG8_SA(1, 0), a3, voffA);
            PG8_BAR; PG8_WAIT_L(0); PG8_MMA(1, 0, At, B0); PG8_BAR; PG8_SCHED;
            PG8_STAGE(PG8_SB(1, 1), b3 + hstep, voffB);
            PG8_WAIT_V(6); PG8_BAR; PG8_MMA(1, 1, At, B1); PG8_BAR;
            }
        }
        if constexpr (ALIGN_EPI) { if (wr == 0) PG8_BAR; }
        if constexpr (!Epi::AFTER_DRAIN) { E(acc, cur, wr, wc, fr, fq); S.done(cur); }
        if (!has_next) break;
#pragma unroll
        for (int a = 0; a < 2; ++a)
#pragma unroll
            for (int b = 0; b < 2; ++b)
#pragma unroll
                for (int m = 0; m < 4; ++m)
#pragma unroll
                    for (int n = 0; n < 2; ++n) acc[a][b][m][n] = (f32x4){0.f, 0.f, 0.f, 0.f};
        cur = nxt; cA = nA; cB = nB; ++ui;
        if constexpr (ALIGN_EPI) { if (wr == 1) PG8_BAR; }
    }
    PG8_WAIT_V(0);
    if constexpr (!ALIGN_EPI) { if (wr == 0) PG8_BAR; }
    PG8_BAR;
    if constexpr (Epi::AFTER_DRAIN) { E.fused(acc, cur, wr, wc, fr, fq, lds, wid, lane); S.done(cur); }
#undef PG8_SA
#undef PG8_SB
#undef PG8_STAGE
#undef PG8_LDA
#undef PG8_LDB
#undef PG8_MMA
#undef PG8_WAIT_V
#undef PG8_WAIT_L
#undef PG8_BAR
#undef PG8_SCHED
}
}

#define LAS __attribute__((address_space(3)))
using namespace pg8;
typedef unsigned u32x2 __attribute__((ext_vector_type(2)));
typedef float f32x16 __attribute__((ext_vector_type(16)));

constexpr int NWAVES = 8, NTHREADS = 512;
constexpr int DM = 1024, MROWS = 16640, RP = 16384, TS = 2048, DIN = 2560, DFF = 2816, NGU = 5632;
constexpr int LDS_BYTES = 139264;
constexpr float LOG2E = 1.4426950408889634f;

constexpr size_t MiB = 1u << 20;
constexpr size_t WS_STAT = 0;
constexpr size_t WS_WQKV = 1 * MiB;
constexpr size_t WS_WO = 7 * MiB;
constexpr size_t WS_WGU = 9 * MiB;
constexpr size_t WS_WD = 21 * MiB;
constexpr size_t WS_XB = 27 * MiB;
constexpr size_t WS_Q = 60 * MiB;
constexpr size_t WS_KP = 77 * MiB;
constexpr size_t WS_KS = 93 * MiB;
constexpr size_t WS_VT = 98 * MiB;
constexpr size_t WS_VTS = 114 * MiB;
constexpr size_t WS_U = 119 * MiB;
constexpr size_t WS_US = 135 * MiB + 512 * 1024;
constexpr size_t WS_OC = 136 * MiB;
constexpr size_t WS_HM = 60 * MiB;
static_assert(WS_HM + (size_t)MROWS * DFF * 2 <= 169 * MiB, "ws map");

struct Args {
    const float *x_prompt, *x_sample, *cache_k, *cache_v, *state_conv, *g_mix, *w_in, *rel_table, *w_dw, *b_dw, *ln_g, *ln_b, *w_out, *g_ffn, *w_gate, *w_up, *w_down, *g_final;
    float* out; unsigned char* ws;
};

__device__ __forceinline__ unsigned cvtpk(float lo, float hi) { unsigned r; asm volatile("v_cvt_pk_bf16_f32 %0, %1, %2" : "=v"(r) : "v"(lo), "v"(hi)); return r; }
__device__ __forceinline__ float wave_sum(float v) {
#pragma unroll
    for (int o = 1; o < 64; o <<= 1) v += __shfl_xor(v, o);
    return v;
}
#define LDS_WAIT() asm volatile("s_waitcnt lgkmcnt(0)" ::: "memory")

__device__ __forceinline__ void transpose_item(const float* W, int ldw, int srccol0, int k0, bf16_t* WT, int ldt, int dstrow0, const float* gs, LAS float* scr, int lane) {
#pragma unroll 8
    for (int i = 0; i < 32; ++i) { const int kk = 2 * i + (lane >> 5); float v = W[(size_t)(k0 + kk) * ldw + srccol0 + (lane & 31)]; if (gs) v *= gs[k0 + kk]; scr[kk * 33 + (lane & 31)] = v; }
    LDS_WAIT(); asm volatile("" ::: "memory");
    const int c = lane & 7;
#pragma unroll
    for (int j = 0; j < 4; ++j) { const int n = (lane >> 3) + 8 * j; const LAS float* s = scr + (8 * c) * 33 + n;
        u32x4 o; o.x = cvtpk(s[0 * 33], s[1 * 33]); o.y = cvtpk(s[2 * 33], s[3 * 33]); o.z = cvtpk(s[4 * 33], s[5 * 33]); o.w = cvtpk(s[6 * 33], s[7 * 33]);
        *(u32x4*)(WT + (size_t)(dstrow0 + n) * ldt + k0 + 8 * c) = o; }
    LDS_WAIT(); asm volatile("" ::: "memory");
}

__device__ __forceinline__ void p0_prologue(const Args& A, LAS unsigned char* lds, int tid, int lane, int wave) {
    unsigned char* ws = A.ws;
    LAS float* scr = (LAS float*)(lds + wave * 16384);
    const int G = gridDim.x, gw = blockIdx.x * NWAVES + wave, NGW = G * NWAVES;
    float* stat = (float*)(ws + WS_STAT);
    for (int i = blockIdx.x * NTHREADS + tid; i < 2 * MROWS; i += G * NTHREADS) stat[MROWS + i] = 0.f;
    constexpr int I_A = 16 * 80, I_B = 16 * 32, I_C = 16 * 176, I_D = 44 * 32, I_E = 8 * 128;
    constexpr int NITEMS = I_A + I_B + I_C + I_D + I_E;
    for (int it = gw; it < NITEMS; it += NGW) {
        int r = it;
        if (r < I_A) { const int kb = r / 80, nb = r % 80, d0 = 32 * nb; int sc = d0;
            if (d0 >= 1536) { const int j = d0 - 1536, t = j >> 8, jj = j & 255; sc = (jj < 128) ? 1536 + 128 * t + jj : 2048 + 128 * t + (jj - 128); }
            transpose_item(A.w_in, DIN, sc, 64 * kb, (bf16_t*)(ws + WS_WQKV), DM, d0, A.g_mix, scr, lane); continue; } r -= I_A;
        if (r < I_B) { const int kb = r / 32, nb = r % 32; transpose_item(A.w_out, DM, 32 * nb, 64 * kb, (bf16_t*)(ws + WS_WO), DM, 32 * nb, nullptr, scr, lane); continue; } r -= I_B;
        if (r < I_C) { const int kb = r / 176, nb = r % 176, d0 = 32 * nb, t = d0 >> 8, jj = d0 & 255;
            transpose_item(jj < 128 ? A.w_gate : A.w_up, DFF, 128 * t + (jj & 127), 64 * kb, (bf16_t*)(ws + WS_WGU), DM, d0, A.g_ffn, scr, lane); continue; } r -= I_C;
        if (r < I_D) { const int kb = r / 32, nb = r % 32; transpose_item(A.w_down, DM, 32 * nb, 64 * kb, (bf16_t*)(ws + WS_WD), DFF, 32 * nb, nullptr, scr, lane); continue; } r -= I_D;
        { const int b = r >> 7, q = r & 127, kb = q >> 4, nb = q & 15;
          transpose_item(A.cache_v + (size_t)b * 512 * 512, 512, 32 * nb, 64 * kb, (bf16_t*)(ws + WS_VTS) + (size_t)b * 512 * 544, 544, 32 * nb, nullptr, scr, lane); }
    }
    bf16_t* XB = (bf16_t*)(ws + WS_XB);
    for (int m = gw; m < MROWS; m += NGW) {
        const float* xr = (m < RP) ? A.x_prompt + (size_t)m * DM : A.x_sample + (size_t)(m - RP) * DM;
        f32x4 v[4]; float s = 0.f;
#pragma unroll
        for (int j = 0; j < 4; ++j) { v[j] = ((const f32x4*)xr)[lane + 64 * j]; s += (v[j].x * v[j].x + v[j].y * v[j].y) + (v[j].z * v[j].z + v[j].w * v[j].w); }
        s = wave_sum(s);
        if (lane == 0) stat[m] = __builtin_amdgcn_rsqf(s * (1.0f / DM) + 1e-6f);
        u32x2* o = (u32x2*)(XB + (size_t)m * DM);
#pragma unroll
        for (int j = 0; j < 4; ++j) o[lane + 64 * j] = (u32x2){cvtpk(v[j].x, v[j].y), cvtpk(v[j].z, v[j].w)};
    }
    for (int m = gw; m < 240; m += NGW) { const int b = m / 30, i = m % 30;
        const f32x4 v0 = ((const f32x4*)(A.state_conv + (size_t)m * 512))[lane], v1 = ((const f32x4*)(A.state_conv + (size_t)m * 512))[lane + 64];
        u32x2* o = (u32x2*)((bf16_t*)(ws + WS_US) + ((size_t)b * 62 + i) * 512); o[lane] = (u32x2){cvtpk(v0.x, v0.y), cvtpk(v0.z, v0.w)}; o[lane + 64] = (u32x2){cvtpk(v1.x, v1.y), cvtpk(v1.z, v1.w)}; }
    bf16_t* KS = (bf16_t*)(ws + WS_KS);
    for (int m = gw; m < 2 * 4096; m += NGW) {
        const int isv = m >= 4096, rr = m & 4095, b = rr >> 9, pos = rr & 511;
        const float* src = (isv ? A.cache_v : A.cache_k) + (size_t)rr * 512;
        const f32x4 v0 = ((const f32x4*)src)[lane], v1 = ((const f32x4*)src)[lane + 64];
        if (pos >= 32) { float* o = A.out + (isv ? OFF_VS : OFF_KS) + ((size_t)b * 512 + pos - 32) * 512; ((f32x4*)o)[lane] = v0; ((f32x4*)o)[lane + 64] = v1; }
        if (!isv) { u32x2* o = (u32x2*)(KS + ((size_t)b * 544 + pos) * 512); o[lane] = (u32x2){cvtpk(v0.x, v0.y), cvtpk(v0.z, v0.w)}; o[lane + 64] = (u32x2){cvtpk(v1.x, v1.y), cvtpk(v1.z, v1.w)}; }
    }
}

template <int NQT>
__device__ __forceinline__ void attn_unit(const bf16_t* Qp, const bf16_t* Kb, const bf16_t* VTb, int vtp, int kt0, int kt1, const LAS float* bt, bf16_t* Op, int lane) {
    const int r = lane & 31, h = lane >> 5;
    const int krow = (r & ~12) | ((r & 4) << 1) | ((r & 8) >> 1);
    constexpr float SC = 0.125f * LOG2E;
    bf16x8 qf[NQT][4];
#pragma unroll
    for (int c = 0; c < NQT; ++c)
#pragma unroll
        for (int s = 0; s < 4; ++s) qf[c][s] = *(const bf16x8*)(Qp + (size_t)(32 * c + r) * 512 + 16 * s + 8 * h);
    f32x16 o[2][NQT]; float mrun[NQT], lrun[NQT];
#pragma unroll
    for (int c = 0; c < NQT; ++c) { mrun[c] = -1e30f; lrun[c] = 0.f;
#pragma unroll
        for (int dt = 0; dt < 2; ++dt)
#pragma unroll
            for (int i = 0; i < 16; ++i) o[dt][c][i] = 0.f; }
    const bf16_t* kp = Kb + (long)krow * 512 + 8 * h;
    const bf16_t* vp = VTb + (long)r * vtp + 8 * h;
    bf16x8 kf[4];
#pragma unroll
    for (int s = 0; s < 4; ++s) kf[s] = *(const bf16x8*)(kp + (long)kt0 * 32 * 512 + 16 * s);
    const float cbias = bt[256];
    bf16x8 vf[2][2];
#pragma unroll
    for (int dt = 0; dt < 2; ++dt)
#pragma unroll
        for (int s = 0; s < 2; ++s) vf[dt][s] = *(const bf16x8*)(vp + (long)(32 * dt) * vtp + 32 * kt0 + 16 * s);
    for (int kt = kt0; kt < kt1; ++kt) {
        const int ktn = (kt + 1 < kt1) ? kt + 1 : kt;
        bf16x8 kn[4], vn[2][2];
#pragma unroll
        for (int s = 0; s < 4; ++s) kn[s] = *(const bf16x8*)(kp + (long)ktn * 32 * 512 + 16 * s);
#pragma unroll
        for (int dt = 0; dt < 2; ++dt)
#pragma unroll
            for (int s = 0; s < 2; ++s) vn[dt][s] = *(const bf16x8*)(vp + (long)(32 * dt) * vtp + 32 * ktn + 16 * s);
        f32x16 sa[NQT];
#pragma unroll
        for (int c = 0; c < NQT; ++c) {
#pragma unroll
            for (int i = 0; i < 16; ++i) sa[c][i] = 0.f;
#pragma unroll
            for (int s = 0; s < 4; ++s) sa[c] = __builtin_amdgcn_mfma_f32_32x32x16_bf16(kf[s], qf[c][s], sa[c], 0, 0, 0); }
        bf16x8 pf[NQT][2];
#pragma unroll
        for (int c = 0; c < NQT; ++c) {
            if (kt <= 11) {
#pragma unroll
                for (int i = 0; i < 16; ++i) sa[c][i] = sa[c][i] * SC + cbias;
            } else {
                const int base = 32 * c + r - 32 * kt - 8 * h + 512;
#pragma unroll
                for (int i = 0; i < 16; ++i) { const int koff = (i & 3) + 4 * ((i >> 2) & 1) + 16 * (i >> 3); int rel = base - koff; rel = rel > 128 ? 128 : rel; sa[c][i] = sa[c][i] * SC + bt[rel + 128]; }
            }
            float mx = sa[c][0];
#pragma unroll
            for (int i = 1; i < 16; ++i) mx = fmaxf(mx, sa[c][i]);
            mx = fmaxf(mx, __shfl_xor(mx, 32));
            const float mnew = fmaxf(mrun[c], mx), alpha = __builtin_amdgcn_exp2f(mrun[c] - mnew);
            mrun[c] = mnew; float ls = 0.f;
#pragma unroll
            for (int i = 0; i < 16; ++i) { sa[c][i] = __builtin_amdgcn_exp2f(sa[c][i] - mnew); ls += sa[c][i]; }
            lrun[c] = lrun[c] * alpha + ls;
#pragma unroll
            for (int dt = 0; dt < 2; ++dt)
#pragma unroll
                for (int i = 0; i < 16; ++i) o[dt][c][i] *= alpha;
#pragma unroll
            for (int s = 0; s < 2; ++s) { u32x4 w; w.x = cvtpk(sa[c][8 * s + 0], sa[c][8 * s + 1]); w.y = cvtpk(sa[c][8 * s + 2], sa[c][8 * s + 3]); w.z = cvtpk(sa[c][8 * s + 4], sa[c][8 * s + 5]); w.w = cvtpk(sa[c][8 * s + 6], sa[c][8 * s + 7]);
                pf[c][s] = __builtin_bit_cast(bf16x8, w); }
        }
#pragma unroll
        for (int dt = 0; dt < 2; ++dt)
#pragma unroll
            for (int c = 0; c < NQT; ++c)
#pragma unroll
                for (int s = 0; s < 2; ++s) o[dt][c] = __builtin_amdgcn_mfma_f32_32x32x16_bf16(vf[dt][s], pf[c][s], o[dt][c], 0, 0, 0);
#pragma unroll
        for (int s = 0; s < 4; ++s) kf[s] = kn[s];
#pragma unroll
        for (int dt = 0; dt < 2; ++dt)
#pragma unroll
            for (int s = 0; s < 2; ++s) vf[dt][s] = vn[dt][s];
    }
#pragma unroll
    for (int c = 0; c < NQT; ++c) { const float l = lrun[c] + __shfl_xor(lrun[c], 32); const float inv = 1.0f / l;
#pragma unroll
        for (int dt = 0; dt < 2; ++dt)
#pragma unroll
            for (int g = 0; g < 4; ++g) { const int d = 32 * dt + 8 * g + 4 * h;
                *(u32x2*)(Op + (size_t)(32 * c + r) * 1024 + d) = (u32x2){cvtpk(o[dt][c][4 * g] * inv, o[dt][c][4 * g + 1] * inv), cvtpk(o[dt][c][4 * g + 2] * inv, o[dt][c][4 * g + 3] * inv)}; } }
}

__device__ __forceinline__ float bf_lo(unsigned w) { return __builtin_bit_cast(float, w << 16); }
__device__ __forceinline__ float bf_hi(unsigned w) { return __builtin_bit_cast(float, w & 0xffff0000u); }

__device__ __forceinline__ void conv_unit(const Args& A, const bf16_t* ub, int tmin, int t0, bf16_t* ob, LAS float* red, int tid, int lane, int wave) {
    const int tg = tid >> 8, cp = tid & 255, c = 2 * cp, tb = t0 + 8 * tg;
    unsigned uw[38];
#pragma unroll
    for (int i = 0; i < 38; ++i) { const int t = tb - 30 + i; const int tc = t < tmin ? tmin : t; uw[i] = *(const unsigned*)(ub + (long)tc * 512 + c); }
    f32x2 wv[31];
#pragma unroll
    for (int j = 0; j < 31; ++j) wv[j] = *(const f32x2*)(A.w_dw + (size_t)j * 512 + c);
    const f32x2 bd = *(const f32x2*)(A.b_dw + c);
    f32x2 in[38];
#pragma unroll
    for (int i = 0; i < 38; ++i) { const int t = tb - 30 + i; float a0 = bf_lo(uw[i]), a1 = bf_hi(uw[i]);
        if (i < 30) { a0 = t < tmin ? 0.f : a0; a1 = t < tmin ? 0.f : a1; }
        in[i] = (f32x2){a0, a1}; }
    f32x2 y[8];
#pragma unroll
    for (int k = 0; k < 8; ++k) y[k] = bd;
#pragma unroll
    for (int j = 0; j < 31; ++j) {
#pragma unroll
        for (int k = 0; k < 8; ++k) y[k] += wv[j] * in[k + j]; }
    float s1[8], s2[8];
#pragma unroll
    for (int k = 0; k < 8; ++k) { s1[k] = wave_sum(y[k].x + y[k].y); s2[k] = wave_sum(y[k].x * y[k].x + y[k].y * y[k].y); }
    if (lane == 0) {
#pragma unroll
        for (int k = 0; k < 8; ++k) { red[wave * 16 + k] = s1[k]; red[wave * 16 + 8 + k] = s2[k]; } }
    __syncthreads();
    const f32x2 lg = *(const f32x2*)(A.ln_g + c), lb = *(const f32x2*)(A.ln_b + c);
#pragma unroll
    for (int k = 0; k < 8; ++k) {
        float S1 = 0.f, S2 = 0.f;
#pragma unroll
        for (int w = 0; w < 4; ++w) { S1 += red[(4 * tg + w) * 16 + k]; S2 += red[(4 * tg + w) * 16 + 8 + k]; }
        const float mean = S1 * (1.0f / 512.0f), var = S2 * (1.0f / 512.0f) - mean * mean, rstd = __builtin_amdgcn_rsqf(var + 1e-5f);
        const float z0 = (y[k].x - mean) * rstd * lg.x + lb.x, z1 = (y[k].y - mean) * rstd * lg.y + lb.y;
        const float o0 = z0 * fast_sigmoid(z0), o1 = z1 * fast_sigmoid(z1);
        *(unsigned*)(ob + (size_t)(tb + k) * 1024 + c) = cvtpk(o0, o1);
    }
    __syncthreads();
}

template <bool BF>
__device__ __forceinline__ void sample_gemm(const bf16_t* As, const bf16_t* Wt, int K, const float* base, float* outf, bf16_t* outb, float* ss, LAS unsigned char* lds) {
    int tid_ = threadIdx.x; asm volatile("" : "+v"(tid_));
    const int lane = tid_ & 63, wave = __builtin_amdgcn_readfirstlane(tid_ >> 6), lr = lane & 15, lq = lane >> 4;
    LAS f32x4* red = (LAS f32x4*)lds;
    for (int tile = blockIdx.x; tile < 256; tile += gridDim.x) {
        const int r0 = (tile >> 4) * 16, c0 = (tile & 15) * 64;
        const int kw = K >> 3, kbeg = wave * kw, nks = kw >> 5;
        f32x4 acc[4];
#pragma unroll
        for (int ct = 0; ct < 4; ++ct) acc[ct] = (f32x4){0.f, 0.f, 0.f, 0.f};
        const bf16_t* ap = As + (size_t)(r0 + lr) * K + kbeg + 8 * lq;
        const bf16_t* bp = Wt + (size_t)(c0 + lr) * K + kbeg + 8 * lq;
#pragma unroll 4
        for (int ks = 0; ks < nks; ++ks) {
            const bf16x8 a = *(const bf16x8*)(ap + 32 * ks);
#pragma unroll
            for (int ct = 0; ct < 4; ++ct) { const bf16x8 b = *(const bf16x8*)(bp + (size_t)(16 * ct) * K + 32 * ks); acc[ct] = __builtin_amdgcn_mfma_f32_16x16x32_bf16(b, a, acc[ct], 0, 0, 0); }
        }
#pragma unroll
        for (int ct = 0; ct < 4; ++ct) red[(wave * 4 + ct) * 64 + lane] = acc[ct];
        __syncthreads();
        if (wave < 4) {
            f32x4 v = (f32x4){0.f, 0.f, 0.f, 0.f};
#pragma unroll
            for (int w = 0; w < 8; ++w) v += red[(w * 4 + wave) * 64 + lane];
            const int row = r0 + lr; const size_t off = (size_t)row * 1024 + c0 + 16 * wave + 4 * lq;
            v += *(const f32x4*)(base + off);
            *(f32x4*)(outf + off) = v;
            if (BF) *(u32x2*)(outb + off) = (u32x2){cvtpk(v[0], v[1]), cvtpk(v[2], v[3])};
            float s = (v[0] * v[0] + v[1] * v[1]) + (v[2] * v[2] + v[3] * v[3]);
            s += __shfl_xor(s, 16); s += __shfl_xor(s, 32);
            if (lq == 0) (void)__hip_atomic_fetch_add(ss + row, s, __ATOMIC_RELAXED, __HIP_MEMORY_SCOPE_AGENT);
        }
        __syncthreads();
    }
}

#ifndef REP_P0
#define REP_P0 1
#endif
#ifndef REP_ATT
#define REP_ATT 1
#endif
#ifndef REP_CONV
#define REP_CONV 1
#endif
#ifndef REP_P1
#define REP_P1 1
#endif
#ifndef REP_P2
#define REP_P2 1
#endif
#ifndef REP_P4
#define REP_P4 1
#endif
__global__ void __launch_bounds__(NTHREADS, 2) fwd_megakernel(Args A) {
    extern __shared__ __attribute__((aligned(16))) unsigned char lds_raw[];
    cg::grid_group grid = cg::this_grid();
    LAS unsigned char* lds = (LAS unsigned char*)lds_raw;
#define FRESH_TID() int tid_ = threadIdx.x; asm volatile("" : "+v"(tid_)); const int tid = tid_, lane = tid & 63, wave = __builtin_amdgcn_readfirstlane(tid >> 6); (void)lane; (void)wave;
    const int G = gridDim.x;
    unsigned char* ws = A.ws;
    float* stat = (float*)(ws + WS_STAT);
    bf16_t* XB = (bf16_t*)(ws + WS_XB);

    for (int rep = 0; rep < REP_P0; ++rep) { FRESH_TID(); p0_prologue(A, lds, tid, lane, wave); }
    grid.sync();

    for (int rep = 0; rep < REP_P1; ++rep) {
        pg8::Gemm g{XB, (const bf16_t*)(ws + WS_WQKV), MROWS, DIN, DM}; pg8::StaticOrder S; S.init(MROWS, DIN, G, (int)blockIdx.x);
        pg8::EpiQKV E{stat, (bf16_t*)(ws + WS_Q), (bf16_t*)(ws + WS_KP), (bf16_t*)(ws + WS_KS), (bf16_t*)(ws + WS_VT), (bf16_t*)(ws + WS_VTS), (bf16_t*)(ws + WS_U), (bf16_t*)(ws + WS_US), A.out};
        pg8::gemm_phase<pg8::EpiQKV, pg8::StaticOrder, true, true>(lds, g, S, E);
    }
    grid.sync();

    for (int rep = 0; rep < REP_P2; ++rep) {
        FRESH_TID();
        LAS float* bt = (LAS float*)lds; LAS float* red = (LAS float*)(lds + 16384);
        for (int i = tid; i < 8 * 257; i += NTHREADS) bt[i] = A.rel_table[i] * LOG2E;
        __syncthreads();
        const bf16_t* Q = (const bf16_t*)(ws + WS_Q); const bf16_t* KP = (const bf16_t*)(ws + WS_KP); const bf16_t* KS = (const bf16_t*)(ws + WS_KS);
        const bf16_t* VT = (const bf16_t*)(ws + WS_VT); const bf16_t* VTS = (const bf16_t*)(ws + WS_VTS); bf16_t* OC = (bf16_t*)(ws + WS_OC);
        for (int rep2 = 0; rep2 < REP_ATT; ++rep2)
        for (int pc = blockIdx.x; pc < 256; pc += G) {
            const int b = pc >> 5, c = pc & 31, hd = wave;
            const long row0 = (long)b * TS + 64 * c;
            attn_unit<2>(Q + row0 * 512 + hd * 64, KP + (row0 - 512) * 512 + hd * 64, VT + ((long)b * 512 + hd * 64) * TS + 64 * c - 512, TS, (16 - 2 * c) > 0 ? (16 - 2 * c) : 0, 18,
                         bt + hd * 257, OC + row0 * 1024 + hd * 64, lane);
            if (c == 0) { const long rs = RP + b * 32; int lane2 = threadIdx.x & 63; asm volatile("" : "+v"(lane2)); const int lane = lane2;
                attn_unit<1>(Q + rs * 512 + hd * 64, KS + (long)b * 544 * 512 + hd * 64, VTS + ((long)b * 512 + hd * 64) * 544, 544, 0, 17, bt + hd * 257, OC + rs * 1024 + hd * 64, lane); }
        }
        __syncthreads();
        int tid2 = threadIdx.x; asm volatile("" : "+v"(tid2));
        for (int rep2 = 0; rep2 < REP_CONV; ++rep2)
        for (int u = blockIdx.x; u < 1040; u += G) {
            const int tid = tid2, lane = tid2 & 63;
            const bool smp = u >= 1024; const int b = smp ? (u - 1024) >> 1 : u >> 7, t0 = smp ? ((u - 1024) & 1) * 16 : (u & 127) * 16;
            const bf16_t* ub = smp ? (const bf16_t*)(ws + WS_US) + ((size_t)b * 62 + 30) * 512 : (const bf16_t*)(ws + WS_U) + (size_t)b * TS * 512;
            conv_unit(A, ub, smp ? -30 : 0, t0, OC + (size_t)(smp ? RP + b * 32 : b * TS) * 1024 + 512, red, tid, lane, wave);
        }
    }
    grid.sync();

    {
        pg8::Gemm g{(const bf16_t*)(ws + WS_OC), (const bf16_t*)(ws + WS_WO), RP, DM, DM}; pg8::StaticOrder S; S.init(RP, DM, G, (int)blockIdx.x);
        pg8::EpiRes<true> E{A.x_prompt, A.x_sample, A.out, XB, stat + MROWS};
        pg8::gemm_phase<pg8::EpiRes<true>, pg8::StaticOrder, true, true>(lds, g, S, E);
        sample_gemm<true>((const bf16_t*)(ws + WS_OC) + (size_t)RP * DM, (const bf16_t*)(ws + WS_WO), DM, A.x_sample, A.out + (size_t)RP * DM, XB + (size_t)RP * DM, stat + MROWS + RP, lds);
    }
    grid.sync();

    for (int rep = 0; rep < REP_P4; ++rep) {
        pg8::Gemm g{XB, (const bf16_t*)(ws + WS_WGU), MROWS, NGU, DM}; pg8::StaticOrder S; S.init(MROWS, NGU, G, (int)blockIdx.x);
        pg8::EpiGU E{stat + MROWS, (bf16_t*)(ws + WS_HM)};
        pg8::gemm_phase<pg8::EpiGU, pg8::StaticOrder, true, true>(lds, g, S, E);
    }
    grid.sync();

    {
        pg8::Gemm g{(const bf16_t*)(ws + WS_HM), (const bf16_t*)(ws + WS_WD), RP, DM, DFF}; pg8::StaticOrder S; S.init(RP, DM, G, (int)blockIdx.x);
        pg8::EpiRes<false> E{A.out, A.out + (size_t)RP * DM, A.out, nullptr, stat + 2 * MROWS};
        pg8::gemm_phase<pg8::EpiRes<false>, pg8::StaticOrder, true, true>(lds, g, S, E);
        sample_gemm<false>((const bf16_t*)(ws + WS_HM) + (size_t)RP * DFF, (const bf16_t*)(ws + WS_WD), DFF, A.out + (size_t)RP * DM, A.out + (size_t)RP * DM, nullptr, stat + 2 * MROWS + RP, lds);
    }
    grid.sync();

    {
        FRESH_TID();
        const int gw = blockIdx.x * NWAVES + wave, NGW = G * NWAVES;
        f32x4 gf[4];
#pragma unroll
        for (int j = 0; j < 4; ++j) gf[j] = ((const f32x4*)A.g_final)[lane + 64 * j];
        for (int m = gw; m < MROWS; m += NGW) {
            f32x4* row = (f32x4*)(A.out + (size_t)m * DM);
            const float rs = __builtin_amdgcn_rsqf(stat[2 * MROWS + m] * (1.0f / DM) + 1e-6f);
#pragma unroll
            for (int j = 0; j < 4; ++j) row[lane + 64 * j] = row[lane + 64 * j] * rs * gf[j];
        }
    }
}

extern "C" void kernel_launch(void* const* d_in, const int* in_sizes, int n_in, void* d_out, int out_size, void* d_ws, size_t ws_size, hipStream_t stream) {
    static int grid = 0;
    if (grid == 0) {
        int dev = 0, cus = 0, per_cu = 0;
        hipGetDevice(&dev);
        hipDeviceGetAttribute(&cus, hipDeviceAttributeMultiprocessorCount, dev);
        if (hipFuncSetAttribute((const void*)fwd_megakernel, hipFuncAttributeMaxDynamicSharedMemorySize, LDS_BYTES) != hipSuccess) { fprintf(stderr, "hipFuncSetAttribute failed\n"); }
        hipOccupancyMaxActiveBlocksPerMultiprocessor(&per_cu, (const void*)fwd_megakernel, NTHREADS, LDS_BYTES);
        (void)hipGetLastError();
        if (per_cu < 1) per_cu = 1;
        grid = cus * per_cu;
    }
    Args a{};
    a.x_prompt = (const float*)d_in[0]; a.x_sample = (const float*)d_in[1]; a.cache_k = (const float*)d_in[2]; a.cache_v = (const float*)d_in[3]; a.state_conv = (const float*)d_in[4];
    a.g_mix = (const float*)d_in[5]; a.w_in = (const float*)d_in[6]; a.rel_table = (const float*)d_in[7]; a.w_dw = (const float*)d_in[8]; a.b_dw = (const float*)d_in[9];
    a.ln_g = (const float*)d_in[10]; a.ln_b = (const float*)d_in[11]; a.w_out = (const float*)d_in[12]; a.g_ffn = (const float*)d_in[13]; a.w_gate = (const float*)d_in[14];
    a.w_up = (const float*)d_in[15]; a.w_down = (const float*)d_in[16]; a.g_final = (const float*)d_in[17];
    a.out = (float*)d_out; a.ws = (unsigned char*)d_ws;
    void* args[] = {&a};
    hipError_t e = hipLaunchCooperativeKernel((const void*)fwd_megakernel, dim3(grid), dim3(NTHREADS), args, LDS_BYTES, stream);
    if (e != hipSuccess) fprintf(stderr, "cooperative launch failed: %s (grid %d)\n", hipGetErrorString(e), grid);
}
```

```cpp
#include <hip/hip_runtime.h>
#include <hip/hip_cooperative_groups.h>
#include <cstdio>
#include <cstdint>
namespace cg = cooperative_groups;
namespace pg8 {
#define PG8_LAS __attribute__((address_space(3)))
typedef unsigned short bf16_t;
typedef short bf16x8 __attribute__((ext_vector_type(8)));
typedef float f32x4 __attribute__((ext_vector_type(4)));
typedef unsigned u32x4 __attribute__((ext_vector_type(4)));
constexpr int BM = 256, BK = 64, HALF = 128, HTB = HALF * BK * 2  , STAGE_BYTES = 8 * HTB, NXCD = 8, WGM = 8;

__host__ __device__ __forceinline__ int lds_byte(int r, int c) { const int st = (r >> 4) * 2 + (c >> 5), rr = r & 15, cc = c & 31, ob = rr * 64 + cc * 2; return st * 1024 + (ob ^ (((ob >> 9) & 1) << 5)); }
__host__ __device__ __forceinline__ void stage_rc(int b, int& R, int& C) { const int st = b / 1024, sb = b % 1024, swz = sb ^ (((sb >> 9) & 1) << 5); R = (st >> 1) * 16 + swz / 64; C = (st & 1) * 32 + (swz % 64) / 2; }
__host__ __device__ __forceinline__ int perm32(int rho) { const int n = rho >> 4, i = rho & 15; return 8 * (i >> 2) + 4 * n + (i & 3); }

struct Unit { int pm, pn; };
struct Gemm { const bf16_t* A; const bf16_t* Bt; int M, N, K; };

struct StaticOrder {
    int nM, nN, nwg, G, c;
    __host__ __device__ void init(int M, int N, int G_, int c_) { nM = M / BM; nN = N / BM; nwg = nM * nN; G = G_; c = c_; }
    __host__ __device__ bool next(int i, Unit& u) const {
        const long L = (long)i * G + c; if (L >= nwg) return false;
        int wgid = (int)L; { const int q = nwg / NXCD, r = nwg % NXCD, xcd = wgid % NXCD, off = wgid / NXCD; wgid = (xcd < r ? xcd * (q + 1) : r * (q + 1) + (xcd - r) * q) + off; }
        const int nig = WGM * nN, gid = wgid / nig, fm = gid * WGM, gsz = (nM - fm) < WGM ? (nM - fm) : WGM;
        u.pm = fm + ((wgid % nig) % gsz); u.pn = (wgid % nig) / gsz; return true;
    }
    __device__ __forceinline__ void a_ready(const Unit&) const {}
    __device__ __forceinline__ void done(const Unit&) const {}
};

__device__ __forceinline__ unsigned cvt_pk_bf16(float lo, float hi) { unsigned r; asm volatile("v_cvt_pk_bf16_f32 %0, %1, %2" : "=v"(r) : "v"(lo), "v"(hi)); return r; }
typedef float f32x2 __attribute__((ext_vector_type(2)));

constexpr int R_PROMPT = 16384, T_SEQ = 2048;
constexpr size_t OFF_Y = 0, OFF_KP = 17039360, OFF_VP = 19136512, OFF_CP = 21233664, OFF_KS = 21356544, OFF_VS = 23453696, OFF_CS = 25550848;

__device__ __forceinline__ u32x4 pack8(const f32x4 a, const f32x4 b) { u32x4 w; w.x = cvt_pk_bf16(a[0], a[1]); w.y = cvt_pk_bf16(a[2], a[3]); w.z = cvt_pk_bf16(b[0], b[1]); w.w = cvt_pk_bf16(b[2], b[3]); return w; }
__device__ __forceinline__ float fast_sigmoid(float g) { return __builtin_amdgcn_rcpf(1.0f + __builtin_amdgcn_exp2f(-1.4426950408889634f * g)); }

struct EpiQKV {
    static constexpr bool PERM = true, AFTER_DRAIN = false;
    const float* rstd0; bf16_t* Q; bf16_t* KP; bf16_t* KS; bf16_t* VT; bf16_t* VTS; bf16_t* U; bf16_t* US; float* out;
    __device__ __forceinline__ void operator()(const f32x4 (&acc)[2][2][4][2], const Unit& u, int wr, int wc, int fr, int fq) const {
        asm volatile("" : "+v"(fr), "+v"(fq));
        const int rbase = u.pm * BM + wr * 64 + fr;
        const bool sample = (u.pm == 64);
        const int kind = u.pn >> 1;
        const int b = sample ? 0 : (u.pm >> 3);
        if (kind == 0) {
            const int col0 = u.pn * BM + wc * 32 + 8 * fq;
#pragma unroll
            for (int ai = 0; ai < 2; ++ai)
#pragma unroll
                for (int m = 0; m < 4; ++m) { const int r = rbase + ai * HALF + m * 16; const float rs = rstd0[r];
#pragma unroll
                    for (int bj = 0; bj < 2; ++bj) *(u32x4*)(Q + (size_t)r * 512 + col0 + bj * HALF) = pack8(acc[ai][bj][m][0] * rs, acc[ai][bj][m][1] * rs); }
        } else if (kind == 1 || kind == 2) {
            const int col0 = (u.pn & 1) * BM + wc * 32 + 8 * fq;
            const bool isv = (kind == 2);
            const bool keep = sample || ((u.pm & 7) >= 6);
            float* ofp = out + (sample ? (isv ? OFF_VS : OFF_KS) : (isv ? OFF_VP : OFF_KP));
#pragma unroll
            for (int ai = 0; ai < 2; ++ai)
#pragma unroll
                for (int m = 0; m < 4; ++m) { const int r = rbase + ai * HALF + m * 16; const float rs = rstd0[r];
                    int sb, st, orow;
                    if (sample) { const int rr = r - R_PROMPT; sb = rr >> 5; st = 512 + (rr & 31); orow = sb * 512 + 480 + (rr & 31); }
                    else { sb = b; st = r - b * T_SEQ; orow = b * 512 + st - 1536; }
#pragma unroll
                    for (int bj = 0; bj < 2; ++bj) { const f32x4 v0 = acc[ai][bj][m][0] * rs, v1 = acc[ai][bj][m][1] * rs; const int c = col0 + bj * HALF;
                        if (keep) { *(f32x4*)(ofp + (size_t)orow * 512 + c) = v0; *(f32x4*)(ofp + (size_t)orow * 512 + c + 4) = v1; }
                        const u32x4 w = pack8(v0, v1);
                        if (!isv) { bf16_t* kd = sample ? KS + ((size_t)sb * 544 + st) * 512 : KP + (size_t)r * 512; *(u32x4*)(kd + c) = w; }
                        else { bf16_t* vd = sample ? VTS + ((size_t)sb * 512 + c) * 544 + st : VT + ((size_t)sb * 512 + c) * T_SEQ + st; const int vp = sample ? 544 : T_SEQ;
                            vd[0] = (bf16_t)(w.x & 0xffffu); vd[vp] = (bf16_t)(w.x >> 16); vd[2 * vp] = (bf16_t)(w.y & 0xffffu); vd[3 * vp] = (bf16_t)(w.y >> 16);
                            vd[4 * vp] = (bf16_t)(w.z & 0xffffu); vd[5 * vp] = (bf16_t)(w.z >> 16); vd[6 * vp] = (bf16_t)(w.w & 0xffffu); vd[7 * vp] = (bf16_t)(w.w >> 16); } } }
        } else {
            const int ch0 = (u.pn - 6) * HALF + wc * 32 + 8 * fq;
            const bool tail = sample || ((u.pm & 7) == 7);
#pragma unroll
            for (int ai = 0; ai < 2; ++ai)
#pragma unroll
                for (int m = 0; m < 4; ++m) { const int r = rbase + ai * HALF + m * 16; const float rs = rstd0[r];
                    f32x4 v[2];
#pragma unroll
                    for (int n = 0; n < 2; ++n) { const f32x4 a = acc[ai][0][m][n] * rs, g = acc[ai][1][m][n] * rs;
                        v[n] = (f32x4){a[0] * fast_sigmoid(g[0]), a[1] * fast_sigmoid(g[1]), a[2] * fast_sigmoid(g[2]), a[3] * fast_sigmoid(g[3])}; }
                    { bf16_t* ud = sample ? US + ((size_t)((r - R_PROMPT) >> 5) * 62 + 30 + ((r - R_PROMPT) & 31)) * 512 : U + (size_t)r * 512; *(u32x4*)(ud + ch0) = pack8(v[0], v[1]); }
                    if (tail) { int orow = -1;
                        if (sample) { const int rr = r - R_PROMPT; if ((rr & 31) >= 2) orow = (rr >> 5) * 30 + (rr & 31) - 2; }
                        else { const int st = r - b * T_SEQ; if (st >= T_SEQ - 30) orow = b * 30 + st - (T_SEQ - 30); }
                        if (orow >= 0) { float* o = out + (sample ? OFF_CS : OFF_CP) + (size_t)orow * 512 + ch0; *(f32x4*)o = v[0]; *(f32x4*)(o + 4) = v[1]; } } }
        }
    }
};

template <bool BF> struct EpiRes {
    static constexpr bool PERM = true, AFTER_DRAIN = false;
    const float* basep; const float* bases; float* outf; bf16_t* outb; float* ss;
    __device__ __forceinline__ void operator()(const f32x4 (&acc)[2][2][4][2], const Unit& u, int wr, int wc, int fr, int fq) const {
        asm volatile("" : "+v"(fr), "+v"(fq));
        const int rbase = u.pm * BM + wr * 64 + fr; const int col0 = u.pn * BM + wc * 32 + 8 * fq;
        const float* bp = (u.pm == 64) ? bases - (size_t)R_PROMPT * 1024 : basep;
#pragma unroll
        for (int ai = 0; ai < 2; ++ai)
#pragma unroll
            for (int m = 0; m < 4; ++m) { const int r = rbase + ai * HALF + m * 16; const size_t off = (size_t)r * 1024 + col0; float s = 0.f;
#pragma unroll
                for (int bj = 0; bj < 2; ++bj) { const f32x4 xa = *(const f32x4*)(bp + off + bj * HALF), xb = *(const f32x4*)(bp + off + bj * HALF + 4);
                    const f32x4 v0 = acc[ai][bj][m][0] + xa, v1 = acc[ai][bj][m][1] + xb;
                    *(f32x4*)(outf + off + bj * HALF) = v0; *(f32x4*)(outf + off + bj * HALF + 4) = v1;
                    if (BF) *(u32x4*)(outb + off + bj * HALF) = pack8(v0, v1);
                    s += (v0[0] * v0[0] + v0[1] * v0[1]) + (v0[2] * v0[2] + v0[3] * v0[3]) + (v1[0] * v1[0] + v1[1] * v1[1]) + (v1[2] * v1[2] + v1[3] * v1[3]); }
                s += __shfl_xor(s, 16); s += __shfl_xor(s, 32);
                if (fq == 0) (void)__hip_atomic_fetch_add(ss + r, s, __ATOMIC_RELAXED, __HIP_MEMORY_SCOPE_AGENT); }
    }
};

struct EpiGU {
    static constexpr bool PERM = true, AFTER_DRAIN = false;
    const float* ss1; bf16_t* HM;
    __device__ __forceinline__ void operator()(const f32x4 (&acc)[2][2][4][2], const Unit& u, int wr, int wc, int fr, int fq) const {
        asm volatile("" : "+v"(fr), "+v"(fq));
        const int rbase = u.pm * BM + wr * 64 + fr; const int ch0 = u.pn * HALF + wc * 32 + 8 * fq;
#pragma unroll
        for (int ai = 0; ai < 2; ++ai)
#pragma unroll
            for (int m = 0; m < 4; ++m) { const int r = rbase + ai * HALF + m * 16; const float rs = __builtin_amdgcn_rsqf(ss1[r] * (1.0f / 1024.0f) + 1e-6f);
                f32x4 v[2];
#pragma unroll
                for (int n = 0; n < 2; ++n) { const f32x4 g = acc[ai][0][m][n] * rs, up = acc[ai][1][m][n] * rs;
                    v[n] = (f32x4){g[0] * fast_sigmoid(g[0]) * up[0], g[1] * fast_sigmoid(g[1]) * up[1], g[2] * fast_sigmoid(g[2]) * up[2], g[3] * fast_sigmoid(g[3]) * up[3]}; }
                *(u32x4*)(HM + (size_t)r * 2816 + ch0) = pack8(v[0], v[1]); }
    }
};
template <class Epi, class Sched, bool ALIGN_EPI = false, bool SP2 = false>
__device__ __forceinline__ void gemm_phase(PG8_LAS unsigned char* lds, const Gemm g, const Sched& S, const Epi& E) {
    int tid_ = threadIdx.x; asm volatile("" : "+v"(tid_)); const int tid = tid_, wid = __builtin_amdgcn_readfirstlane(tid >> 6), lane = tid & 63, wr = wid >> 2, wc = wid & 3, fr = lane & 15, fq = lane >> 4;
    const int K = g.K, nt = K / BK;
    unsigned voffA[2], voffB[2];
#pragma unroll
    for (int i = 0; i < 2; ++i) { int R, C; stage_rc(tid * 16 + i * 8192, R, C); const int Rb = Epi::PERM ? ((R & ~31) + perm32(R & 31)) : R;
        voffA[i] = (unsigned)(R * K + C) * 2u; voffB[i] = (unsigned)(Rb * K + C) * 2u; }
    const size_t kstep = (size_t)(BK * 2);
    const size_t hstep = (size_t)HALF * K * 2;
    const size_t tstep = 2 * hstep;
    const unsigned ldsw = (unsigned)wid * 1024u;
    const int aoff = lds_byte(wr * 64 + fr, fq * 8), boff = lds_byte(wc * 32 + fr, fq * 8);
#define PG8_SA(b, h) (((b) * 2 + (h)) * HTB)
#define PG8_SB(b, h) ((4 + (b) * 2 + (h)) * HTB)
#define PG8_STAGE(bufoff, gbase, voff) do { _Pragma("unroll") for (int _i = 0; _i < 2; ++_i) \
        __builtin_amdgcn_global_load_lds((const unsigned*)((const char*)(gbase) + (voff)[_i]), (PG8_LAS unsigned*)(lds + (bufoff) + ldsw + _i * 8192), 16, 0, 0); } while (0)
#define PG8_LDA(dst, b, h) do { _Pragma("unroll") for (int m = 0; m < 4; ++m) _Pragma("unroll") for (int k = 0; k < 2; ++k) dst[m][k] = *(const PG8_LAS bf16x8*)(lds + PG8_SA(b, h) + aoff + m * 2048 + k * 1024); } while (0)
#define PG8_LDB(dst, b, h) do { _Pragma("unroll") for (int n = 0; n < 2; ++n) _Pragma("unroll") for (int k = 0; k < 2; ++k) dst[n][k] = *(const PG8_LAS bf16x8*)(lds + PG8_SB(b, h) + boff + n * 2048 + k * 1024); } while (0)
#define PG8_MMA(ai, bj, At, Bt) do { __builtin_amdgcn_s_setprio(1); _Pragma("unroll") for (int m = 0; m < 4; ++m) _Pragma("unroll") for (int n = 0; n < 2; ++n) _Pragma("unroll") for (int k = 0; k < 2; ++k) \
        acc[ai][bj][m][n] = __builtin_amdgcn_mfma_f32_16x16x32_bf16(Bt[n][k], At[m][k], acc[ai][bj][m][n], 0, 0, 0); __builtin_amdgcn_s_setprio(0); } while (0)
#define PG8_WAIT_V(n) asm volatile("s_waitcnt vmcnt(" #n ")" ::: "memory")
#define PG8_WAIT_L(n) asm volatile("s_waitcnt lgkmcnt(" #n ")" ::: "memory")
#define PG8_BAR __builtin_amdgcn_s_barrier()
#define PG8_SCHED __builtin_amdgcn_sched_barrier(0)
    Unit cur, nxt; int ui = 0;
    if (!S.next(0, cur)) return;
    f32x4 acc[2][2][4][2];
#pragma unroll
    for (int a = 0; a < 2; ++a)
#pragma unroll
        for (int b = 0; b < 2; ++b)
#pragma unroll
            for (int m = 0; m < 4; ++m)
#pragma unroll
                for (int n = 0; n < 2; ++n) acc[a][b][m][n] = (f32x4){0.f, 0.f, 0.f, 0.f};
    bf16x8 At[4][2], B0[2][2], B1[2][2];
    const char* cA = (const char*)g.A + (size_t)cur.pm * tstep; const char* cB = (const char*)g.Bt + (size_t)cur.pn * tstep;
    S.a_ready(cur);
    if constexpr (SP2) {
        PG8_STAGE(PG8_SB(0, 0), cB, voffB); PG8_STAGE(PG8_SB(0, 1), cB + hstep, voffB); PG8_STAGE(PG8_SA(0, 0), cA, voffA); PG8_STAGE(PG8_SA(0, 1), cA + hstep, voffA);
        if (wr == 1) PG8_BAR;
        PG8_WAIT_V(2); PG8_BAR;
        PG8_STAGE(PG8_SB(1, 0), cB + kstep, voffB); PG8_STAGE(PG8_SA(1, 0), cA + kstep, voffA); PG8_STAGE(PG8_SB(1, 1), cB + hstep + kstep, voffB);
        PG8_WAIT_V(6); PG8_BAR;
    } else {
        PG8_STAGE(PG8_SB(0, 0), cB, voffB); PG8_STAGE(PG8_SA(0, 0), cA, voffA); PG8_STAGE(PG8_SB(0, 1), cB + hstep, voffB); PG8_STAGE(PG8_SA(0, 1), cA + hstep, voffA);
        if (wr == 1) PG8_BAR;
        PG8_WAIT_V(4); PG8_BAR;
        PG8_STAGE(PG8_SB(1, 0), cB + kstep, voffB); PG8_STAGE(PG8_SA(1, 0), cA + kstep, voffA); PG8_STAGE(PG8_SB(1, 1), cB + hstep + kstep, voffB);
        PG8_WAIT_V(6); PG8_BAR;
    }
    for (;;) {
        const bool has_next = S.next(ui + 1, nxt);
        const char* nA = has_next ? (const char*)g.A + (size_t)nxt.pm * tstep : cA; const char* nB = has_next ? (const char*)g.Bt + (size_t)nxt.pn * tstep : cB;
        for (int t = 0; t < nt; t += 2) {
            const bool last = (t == nt - 2);
            const char* a1 = cA + (size_t)(t + 1) * kstep;
            const char* a2 = last ? nA : cA + (size_t)(t + 2) * kstep; const char* b2 = last ? nB : cB + (size_t)(t + 2) * kstep;
            const char* a3 = a2 + kstep; const char* b3 = b2 + kstep;
            if (last && has_next) S.a_ready(nxt);
            if constexpr (SP2) {
            PG8_LDB(B0, 0, 0); PG8_LDB(B1, 0, 1); PG8_SCHED; PG8_LDA(At, 0, 0); PG8_STAGE(PG8_SA(1, 1), a1 + hstep, voffA);
            PG8_WAIT_V(8); PG8_WAIT_L(0); PG8_BAR; PG8_MMA(0, 0, At, B0); PG8_MMA(0, 1, At, B1); PG8_BAR; PG8_SCHED;
            PG8_LDA(At, 0, 1); PG8_STAGE(PG8_SB(0, 0), b2, voffB); PG8_STAGE(PG8_SB(0, 1), b2 + hstep, voffB); PG8_STAGE(PG8_SA(0, 0), a2, voffA);
            PG8_WAIT_V(8); PG8_WAIT_L(0); PG8_BAR; PG8_MMA(1, 0, At, B0); PG8_MMA(1, 1, At, B1); PG8_BAR; PG8_SCHED;
            PG8_LDB(B0, 1, 0); PG8_LDB(B1, 1, 1); PG8_SCHED; PG8_LDA(At, 1, 0); PG8_STAGE(PG8_SA(0, 1), a2 + hstep, voffA);
            PG8_WAIT_V(8); PG8_WAIT_L(0); PG8_BAR; PG8_MMA(0, 0, At, B0); PG8_MMA(0, 1, At, B1); PG8_BAR; PG8_SCHED;
            PG8_LDA(At, 1, 1); PG8_STAGE(PG8_SB(1, 0), b3, voffB); PG8_STAGE(PG8_SB(1, 1), b3 + hstep, voffB); PG8_STAGE(PG8_SA(1, 0), a3, voffA);
            PG8_WAIT_V(8); PG8_WAIT_L(0); PG8_BAR; PG8_MMA(1, 0, At, B0); PG8_MMA(1, 1, At, B1); PG8_BAR; PG8_SCHED;
            } else {
            PG8_LDB(B0, 0, 0); PG8_SCHED; PG8_LDA(At, 0, 0); PG8_STAGE(PG8_SA(1, 1), a1 + hstep, voffA);
            PG8_WAIT_L(8); PG8_BAR; PG8_WAIT_L(0); PG8_MMA(0, 0, At, B0); PG8_BAR; PG8_SCHED;
            PG8_LDB(B1, 0, 1); PG8_STAGE(PG8_SB(0, 0), b2, voffB);
            PG8_BAR; PG8_WAIT_L(0); PG8_MMA(0, 1, At, B1); PG8_BAR;
            PG8_LDA(At, 0, 1); PG8_STAGE(PG8_SA(0, 0), a2, voffA);
            PG8_BAR; PG8_WAIT_L(0); PG8_MMA(1, 0, At, B0); PG8_BAR; PG8_SCHED;
            PG8_STAGE(PG8_SB(0, 1), b2 + hstep, voffB);
            PG8_WAIT_V(6); PG8_BAR; PG8_MMA(1, 1, At, B1); PG8_BAR;
            PG8_LDB(B0, 1, 0); PG8_SCHED; PG8_LDA(At, 1, 0); PG8_STAGE(PG8_SA(0, 1), a2 + hstep, voffA);
            PG8_WAIT_L(8); PG8_BAR; PG8_WAIT_L(0); PG8_MMA(0, 0, At, B0); PG8_BAR; PG8_SCHED;
            PG8_LDB(B1, 1, 1); PG8_STAGE(PG8_SB(1, 0), b3, voffB);
            PG8_BAR; PG8_WAIT_L(0); PG8_MMA(0, 1, At, B1); PG8_BAR;
            PG8_LDA(At, 1, 1); PG8_STAGE(PG8_SA(1, 0), a3, voffA);
            PG8_BAR; PG8_WAIT_L(0); PG8_MMA(1, 0, At, B0); PG8_BAR; PG8_SCHED;
            PG8_STAGE(PG8_SB(1, 1), b3 + hstep, voffB);
            PG8_WAIT_V(6); PG8_BAR; PG8_MMA(1, 1, At, B1); PG8_BAR;
            }
        }
        if constexpr (ALIGN_EPI) { if (wr == 0) PG8_BAR; }
        if constexpr (!Epi::AFTER_DRAIN) { E(acc, cur, wr, wc, fr, fq); S.done(cur); }
        if (!has_next) break;
#pragma unroll
        for (int a = 0; a < 2; ++a)
#pragma unroll
            for (int b = 0; b < 2; ++b)
#pragma unroll
                for (int m = 0; m < 4; ++m)
#pragma unroll
                    for (int n = 0; n < 2; ++n) acc[a][b][m][n] = (f32x4){0.f, 0.f, 0.f, 0.f};
        cur = nxt; cA = nA; cB = nB; ++ui;
        if constexpr (ALIGN_EPI) { if (wr == 1) PG8_BAR; }
    }
    PG8_WAIT_V(0);
    if constexpr (!ALIGN_EPI) { if (wr == 0) PG8_BAR; }
    PG8_BAR;
    if constexpr (Epi::AFTER_DRAIN) { E.fused(acc, cur, wr, wc, fr, fq, lds, wid, lane); S.done(cur); }
#undef PG8_SA
#undef PG8_SB
#undef PG8_STAGE
#undef PG8_LDA
#undef PG8_LDB
#undef PG8_MMA
#undef PG8_WAIT_V
#undef PG8_WAIT_L
#undef PG8_BAR
#undef PG8_SCHED
}
}

#define LAS __attribute__((address_space(3)))
using namespace pg8;
typedef unsigned u32x2 __attribute__((ext_vector_type(2)));
typedef float f32x16 __attribute__((ext_vector_type(16)));

constexpr int NWAVES = 8, NTHREADS = 512;
constexpr int DM = 1024, MROWS = 16640, RP = 16384, TS = 2048, DIN = 2560, DFF = 2816, NGU = 5632;
constexpr int LDS_BYTES = 139264;
constexpr float LOG2E = 1.4426950408889634f;

constexpr size_t MiB = 1u << 20;
constexpr size_t WS_STAT = 0;
constexpr size_t WS_BAR = 512 * 1024;
constexpr size_t WS_WQKV = 1 * MiB;
constexpr size_t WS_WO = 7 * MiB;
constexpr size_t WS_WGU = 9 * MiB;
constexpr size_t WS_WD = 21 * MiB;
constexpr size_t WS_XB = 27 * MiB;
constexpr size_t WS_Q = 60 * MiB;
constexpr size_t WS_KP = 77 * MiB;
constexpr size_t WS_KS = 93 * MiB;
constexpr size_t WS_VT = 98 * MiB;
constexpr size_t WS_VTS = 114 * MiB;
constexpr size_t WS_U = 119 * MiB;
constexpr size_t WS_US = 135 * MiB + 512 * 1024;
constexpr size_t WS_OC = 136 * MiB;
constexpr size_t WS_HM = 60 * MiB;
static_assert(WS_HM + (size_t)MROWS * DFF * 2 <= 169 * MiB, "ws map");

struct Args {
    const float *x_prompt, *x_sample, *cache_k, *cache_v, *state_conv, *g_mix, *w_in, *rel_table, *w_dw, *b_dw, *ln_g, *ln_b, *w_out, *g_ffn, *w_gate, *w_up, *w_down, *g_final;
    float* out; unsigned char* ws; int use_cg; int pad;
};

__device__ __forceinline__ unsigned cvtpk(float lo, float hi) { unsigned r; asm volatile("v_cvt_pk_bf16_f32 %0, %1, %2" : "=v"(r) : "v"(lo), "v"(hi)); return r; }
__device__ __forceinline__ float wave_sum(float v) {
#pragma unroll
    for (int o = 1; o < 64; o <<= 1) v += __shfl_xor(v, o);
    return v;
}
#define LDS_WAIT() asm volatile("s_waitcnt lgkmcnt(0)" ::: "memory")

__device__ __forceinline__ void transpose_item(const float* W, int ldw, int srccol0, int k0, bf16_t* WT, int ldt, int dstrow0, const float* gs, LAS float* scr, int lane) {
#pragma unroll 8
    for (int i = 0; i < 32; ++i) { const int kk = 2 * i + (lane >> 5); float v = W[(size_t)(k0 + kk) * ldw + srccol0 + (lane & 31)]; if (gs) v *= gs[k0 + kk]; scr[kk * 33 + (lane & 31)] = v; }
    LDS_WAIT(); asm volatile("" ::: "memory");
    const int c = lane & 7;
#pragma unroll
    for (int j = 0; j < 4; ++j) { const int n = (lane >> 3) + 8 * j; const LAS float* s = scr + (8 * c) * 33 + n;
        u32x4 o; o.x = cvtpk(s[0 * 33], s[1 * 33]); o.y = cvtpk(s[2 * 33], s[3 * 33]); o.z = cvtpk(s[4 * 33], s[5 * 33]); o.w = cvtpk(s[6 * 33], s[7 * 33]);
        *(u32x4*)(WT + (size_t)(dstrow0 + n) * ldt + k0 + 8 * c) = o; }
    LDS_WAIT(); asm volatile("" ::: "memory");
}

__device__ __forceinline__ void p0_prologue(const Args& A, LAS unsigned char* lds, int tid, int lane, int wave) {
    unsigned char* ws = A.ws;
    LAS float* scr = (LAS float*)(lds + wave * 16384);
    const int G = gridDim.x, gw = blockIdx.x * NWAVES + wave, NGW = G * NWAVES;
    float* stat = (float*)(ws + WS_STAT);
    for (int i = blockIdx.x * NTHREADS + tid; i < 2 * MROWS; i += G * NTHREADS) stat[MROWS + i] = 0.f;
    constexpr int I_A = 16 * 80, I_B = 16 * 32, I_C = 16 * 176, I_D = 44 * 32, I_E = 8 * 128;
    constexpr int NITEMS = I_A + I_B + I_C + I_D + I_E;
    for (int it = gw; it < NITEMS; it += NGW) {
        int r = it;
        if (r < I_A) { const int kb = r / 80, nb = r % 80, d0 = 32 * nb; int sc = d0;
            if (d0 >= 1536) { const int j = d0 - 1536, t = j >> 8, jj = j & 255; sc = (jj < 128) ? 1536 + 128 * t + jj : 2048 + 128 * t + (jj - 128); }
            transpose_item(A.w_in, DIN, sc, 64 * kb, (bf16_t*)(ws + WS_WQKV), DM, d0, A.g_mix, scr, lane); continue; } r -= I_A;
        if (r < I_B) { const int kb = r / 32, nb = r % 32; transpose_item(A.w_out, DM, 32 * nb, 64 * kb, (bf16_t*)(ws + WS_WO), DM, 32 * nb, nullptr, scr, lane); continue; } r -= I_B;
        if (r < I_C) { const int kb = r / 176, nb = r % 176, d0 = 32 * nb, t = d0 >> 8, jj = d0 & 255;
            transpose_item(jj < 128 ? A.w_gate : A.w_up, DFF, 128 * t + (jj & 127), 64 * kb, (bf16_t*)(ws + WS_WGU), DM, d0, A.g_ffn, scr, lane); continue; } r -= I_C;
        if (r < I_D) { const int kb = r / 32, nb = r % 32; transpose_item(A.w_down, DM, 32 * nb, 64 * kb, (bf16_t*)(ws + WS_WD), DFF, 32 * nb, nullptr, scr, lane); continue; } r -= I_D;
        { const int b = r >> 7, q = r & 127, kb = q >> 4, nb = q & 15;
          transpose_item(A.cache_v + (size_t)b * 512 * 512, 512, 32 * nb, 64 * kb, (bf16_t*)(ws + WS_VTS) + (size_t)b * 512 * 544, 544, 32 * nb, nullptr, scr, lane); }
    }
    bf16_t* XB = (bf16_t*)(ws + WS_XB);
    for (int m = gw; m < MROWS; m += NGW) {
        const float* xr = (m < RP) ? A.x_prompt + (size_t)m * DM : A.x_sample + (size_t)(m - RP) * DM;
        f32x4 v[4]; float s = 0.f;
#pragma unroll
        for (int j = 0; j < 4; ++j) { v[j] = ((const f32x4*)xr)[lane + 64 * j]; s += (v[j].x * v[j].x + v[j].y * v[j].y) + (v[j].z * v[j].z + v[j].w * v[j].w); }
        s = wave_sum(s);
        if (lane == 0) stat[m] = __builtin_amdgcn_rsqf(s * (1.0f / DM) + 1e-6f);
        u32x2* o = (u32x2*)(XB + (size_t)m * DM);
#pragma unroll
        for (int j = 0; j < 4; ++j) o[lane + 64 * j] = (u32x2){cvtpk(v[j].x, v[j].y), cvtpk(v[j].z, v[j].w)};
    }
    for (int m = gw; m < 240; m += NGW) { const int b = m / 30, i = m % 30;
        const f32x4 v0 = ((const f32x4*)(A.state_conv + (size_t)m * 512))[lane], v1 = ((const f32x4*)(A.state_conv + (size_t)m * 512))[lane + 64];
        u32x2* o = (u32x2*)((bf16_t*)(ws + WS_US) + ((size_t)b * 62 + i) * 512); o[lane] = (u32x2){cvtpk(v0.x, v0.y), cvtpk(v0.z, v0.w)}; o[lane + 64] = (u32x2){cvtpk(v1.x, v1.y), cvtpk(v1.z, v1.w)}; }
    bf16_t* KS = (bf16_t*)(ws + WS_KS);
    for (int m = gw; m < 2 * 4096; m += NGW) {
        const int isv = m >= 4096, rr = m & 4095, b = rr >> 9, pos = rr & 511;
        const float* src = (isv ? A.cache_v : A.cache_k) + (size_t)rr * 512;
        const f32x4 v0 = ((const f32x4*)src)[lane], v1 = ((const f32x4*)src)[lane + 64];
        if (pos >= 32) { float* o = A.out + (isv ? OFF_VS : OFF_KS) + ((size_t)b * 512 + pos - 32) * 512; ((f32x4*)o)[lane] = v0; ((f32x4*)o)[lane + 64] = v1; }
        if (!isv) { u32x2* o = (u32x2*)(KS + ((size_t)b * 544 + pos) * 512); o[lane] = (u32x2){cvtpk(v0.x, v0.y), cvtpk(v0.z, v0.w)}; o[lane + 64] = (u32x2){cvtpk(v1.x, v1.y), cvtpk(v1.z, v1.w)}; }
    }
}

template <int NQT>
__device__ __forceinline__ void attn_unit(const bf16_t* Qp, const bf16_t* Kb, const bf16_t* VTb, int vtp, int kt0, int kt1, const LAS float* bt, bf16_t* Op, int lane) {
    const int r = lane & 31, h = lane >> 5;
    const int krow = (r & ~12) | ((r & 4) << 1) | ((r & 8) >> 1);
    constexpr float SC = 0.125f * LOG2E;
    bf16x8 qf[NQT][4];
#pragma unroll
    for (int c = 0; c < NQT; ++c)
#pragma unroll
        for (int s = 0; s < 4; ++s) qf[c][s] = *(const bf16x8*)(Qp + (size_t)(32 * c + r) * 512 + 16 * s + 8 * h);
    f32x16 o[2][NQT]; float mrun[NQT], lrun[NQT];
#pragma unroll
    for (int c = 0; c < NQT; ++c) { mrun[c] = -1e30f; lrun[c] = 0.f;
#pragma unroll
        for (int dt = 0; dt < 2; ++dt)
#pragma unroll
            for (int i = 0; i < 16; ++i) o[dt][c][i] = 0.f; }
    const bf16_t* kp = Kb + (long)krow * 512 + 8 * h;
    const bf16_t* vp = VTb + (long)r * vtp + 8 * h;
    bf16x8 kf[4];
#pragma unroll
    for (int s = 0; s < 4; ++s) kf[s] = *(const bf16x8*)(kp + (long)kt0 * 32 * 512 + 16 * s);
    const float cbias = bt[256];
    bf16x8 vf[2][2];
#pragma unroll
    for (int dt = 0; dt < 2; ++dt)
#pragma unroll
        for (int s = 0; s < 2; ++s) vf[dt][s] = *(const bf16x8*)(vp + (long)(32 * dt) * vtp + 32 * kt0 + 16 * s);
    for (int kt = kt0; kt < kt1; ++kt) {
        const int ktn = (kt + 1 < kt1) ? kt + 1 : kt;
        bf16x8 kn[4], vn[2][2];
#pragma unroll
        for (int s = 0; s < 4; ++s) kn[s] = *(const bf16x8*)(kp + (long)ktn * 32 * 512 + 16 * s);
#pragma unroll
        for (int dt = 0; dt < 2; ++dt)
#pragma unroll
            for (int s = 0; s < 2; ++s) vn[dt][s] = *(const bf16x8*)(vp + (long)(32 * dt) * vtp + 32 * ktn + 16 * s);
        f32x16 sa[NQT];
#pragma unroll
        for (int c = 0; c < NQT; ++c) {
#pragma unroll
            for (int i = 0; i < 16; ++i) sa[c][i] = 0.f;
#pragma unroll
            for (int s = 0; s < 4; ++s) sa[c] = __builtin_amdgcn_mfma_f32_32x32x16_bf16(kf[s], qf[c][s], sa[c], 0, 0, 0); }
        bf16x8 pf[NQT][2];
#pragma unroll
        for (int c = 0; c < NQT; ++c) {
            if (kt <= 11) {
#pragma unroll
                for (int i = 0; i < 16; ++i) sa[c][i] = sa[c][i] * SC + cbias;
            } else {
                const int base = 32 * c + r - 32 * kt - 8 * h + 512;
#pragma unroll
                for (int i = 0; i < 16; ++i) { const int koff = (i & 3) + 4 * ((i >> 2) & 1) + 16 * (i >> 3); int rel = base - koff; rel = rel > 128 ? 128 : rel; sa[c][i] = sa[c][i] * SC + bt[rel + 128]; }
            }
            float mx = sa[c][0];
#pragma unroll
            for (int i = 1; i < 16; ++i) mx = fmaxf(mx, sa[c][i]);
            mx = fmaxf(mx, __shfl_xor(mx, 32));
            const float mnew = fmaxf(mrun[c], mx), alpha = __builtin_amdgcn_exp2f(mrun[c] - mnew);
            mrun[c] = mnew; float ls = 0.f;
#pragma unroll
            for (int i = 0; i < 16; ++i) { sa[c][i] = __builtin_amdgcn_exp2f(sa[c][i] - mnew); ls += sa[c][i]; }
            lrun[c] = lrun[c] * alpha + ls;
#pragma unroll
            for (int dt = 0; dt < 2; ++dt)
#pragma unroll
                for (int i = 0; i < 16; ++i) o[dt][c][i] *= alpha;
#pragma unroll
            for (int s = 0; s < 2; ++s) { u32x4 w; w.x = cvtpk(sa[c][8 * s + 0], sa[c][8 * s + 1]); w.y = cvtpk(sa[c][8 * s + 2], sa[c][8 * s + 3]); w.z = cvtpk(sa[c][8 * s + 4], sa[c][8 * s + 5]); w.w = cvtpk(sa[c][8 * s + 6], sa[c][8 * s + 7]);
                pf[c][s] = __builtin_bit_cast(bf16x8, w); }
        }
#pragma unroll
        for (int dt = 0; dt < 2; ++dt)
#pragma unroll
            for (int c = 0; c < NQT; ++c)
#pragma unroll
                for (int s = 0; s < 2; ++s) o[dt][c] = __builtin_amdgcn_mfma_f32_32x32x16_bf16(vf[dt][s], pf[c][s], o[dt][c], 0, 0, 0);
#pragma unroll
        for (int s = 0; s < 4; ++s) kf[s] = kn[s];
#pragma unroll
        for (int dt = 0; dt < 2; ++dt)
#pragma unroll
            for (int s = 0; s < 2; ++s) vf[dt][s] = vn[dt][s];
    }
#pragma unroll
    for (int c = 0; c < NQT; ++c) { const float l = lrun[c] + __shfl_xor(lrun[c], 32); const float inv = 1.0f / l;
#pragma unroll
        for (int dt = 0; dt < 2; ++dt)
#pragma unroll
            for (int g = 0; g < 4; ++g) { const int d = 32 * dt + 8 * g + 4 * h;
                *(u32x2*)(Op + (size_t)(32 * c + r) * 1024 + d) = (u32x2){cvtpk(o[dt][c][4 * g] * inv, o[dt][c][4 * g + 1] * inv), cvtpk(o[dt][c][4 * g + 2] * inv, o[dt][c][4 * g + 3] * inv)}; } }
}

__device__ __forceinline__ float bf_lo(unsigned w) { return __builtin_bit_cast(float, w << 16); }
__device__ __forceinline__ float bf_hi(unsigned w) { return __builtin_bit_cast(float, w & 0xffff0000u); }

__device__ __forceinline__ void conv_unit(const Args& A, const bf16_t* ub, int tmin, int t0, bf16_t* ob, LAS float* red, int tid, int lane, int wave) {
    const int tg = tid >> 8, cp = tid & 255, c = 2 * cp, tb = t0 + 8 * tg;
    unsigned uw[38];
#pragma unroll
    for (int i = 0; i < 38; ++i) { const int t = tb - 30 + i; const int tc = t < tmin ? tmin : t; uw[i] = *(const unsigned*)(ub + (long)tc * 512 + c); }
    f32x2 wv[31];
#pragma unroll
    for (int j = 0; j < 31; ++j) wv[j] = *(const f32x2*)(A.w_dw + (size_t)j * 512 + c);
    const f32x2 bd = *(const f32x2*)(A.b_dw + c);
    f32x2 in[38];
#pragma unroll
    for (int i = 0; i < 38; ++i) { const int t = tb - 30 + i; float a0 = bf_lo(uw[i]), a1 = bf_hi(uw[i]);
        if (i < 30) { a0 = t < tmin ? 0.f : a0; a1 = t < tmin ? 0.f : a1; }
        in[i] = (f32x2){a0, a1}; }
    f32x2 y[8];
#pragma unroll
    for (int k = 0; k < 8; ++k) y[k] = bd;
#pragma unroll
    for (int j = 0; j < 31; ++j) {
#pragma unroll
        for (int k = 0; k < 8; ++k) y[k] += wv[j] * in[k + j]; }
    float s1[8], s2[8];
#pragma unroll
    for (int k = 0; k < 8; ++k) { s1[k] = wave_sum(y[k].x + y[k].y); s2[k] = wave_sum(y[k].x * y[k].x + y[k].y * y[k].y); }
    if (lane == 0) {
#pragma unroll
        for (int k = 0; k < 8; ++k) { red[wave * 16 + k] = s1[k]; red[wave * 16 + 8 + k] = s2[k]; } }
    __syncthreads();
    const f32x2 lg = *(const f32x2*)(A.ln_g + c), lb = *(const f32x2*)(A.ln_b + c);
#pragma unroll
    for (int k = 0; k < 8; ++k) {
        float S1 = 0.f, S2 = 0.f;
#pragma unroll
        for (int w = 0; w < 4; ++w) { S1 += red[(4 * tg + w) * 16 + k]; S2 += red[(4 * tg + w) * 16 + 8 + k]; }
        const float mean = S1 * (1.0f / 512.0f), var = S2 * (1.0f / 512.0f) - mean * mean, rstd = __builtin_amdgcn_rsqf(var + 1e-5f);
        const float z0 = (y[k].x - mean) * rstd * lg.x + lb.x, z1 = (y[k].y - mean) * rstd * lg.y + lb.y;
        const float o0 = z0 * fast_sigmoid(z0), o1 = z1 * fast_sigmoid(z1);
        *(unsigned*)(ob + (size_t)(tb + k) * 1024 + c) = cvtpk(o0, o1);
    }
    __syncthreads();
}

template <bool BF>
__device__ __forceinline__ void sample_gemm(const bf16_t* As, const bf16_t* Wt, int K, const float* base, float* outf, bf16_t* outb, float* ss, LAS unsigned char* lds) {
    int tid_ = threadIdx.x; asm volatile("" : "+v"(tid_));
    const int lane = tid_ & 63, wave = __builtin_amdgcn_readfirstlane(tid_ >> 6), lr = lane & 15, lq = lane >> 4;
    LAS f32x4* red = (LAS f32x4*)lds;
    for (int tile = blockIdx.x; tile < 256; tile += gridDim.x) {
        const int r0 = (tile >> 4) * 16, c0 = (tile & 15) * 64;
        const int kw = K >> 3, kbeg = wave * kw, nks = kw >> 5;
        f32x4 acc[4];
#pragma unroll
        for (int ct = 0; ct < 4; ++ct) acc[ct] = (f32x4){0.f, 0.f, 0.f, 0.f};
        const bf16_t* ap = As + (size_t)(r0 + lr) * K + kbeg + 8 * lq;
        const bf16_t* bp = Wt + (size_t)(c0 + lr) * K + kbeg + 8 * lq;
#pragma unroll 4
        for (int ks = 0; ks < nks; ++ks) {
            const bf16x8 a = *(const bf16x8*)(ap + 32 * ks);
#pragma unroll
            for (int ct = 0; ct < 4; ++ct) { const bf16x8 b = *(const bf16x8*)(bp + (size_t)(16 * ct) * K + 32 * ks); acc[ct] = __builtin_amdgcn_mfma_f32_16x16x32_bf16(b, a, acc[ct], 0, 0, 0); }
        }
#pragma unroll
        for (int ct = 0; ct < 4; ++ct) red[(wave * 4 + ct) * 64 + lane] = acc[ct];
        __syncthreads();
        if (wave < 4) {
            f32x4 v = (f32x4){0.f, 0.f, 0.f, 0.f};
#pragma unroll
            for (int w = 0; w < 8; ++w) v += red[(w * 4 + wave) * 64 + lane];
            const int row = r0 + lr; const size_t off = (size_t)row * 1024 + c0 + 16 * wave + 4 * lq;
            v += *(const f32x4*)(base + off);
            *(f32x4*)(outf + off) = v;
            if (BF) *(u32x2*)(outb + off) = (u32x2){cvtpk(v[0], v[1]), cvtpk(v[2], v[3])};
            float s = (v[0] * v[0] + v[1] * v[1]) + (v[2] * v[2] + v[3] * v[3]);
            s += __shfl_xor(s, 16); s += __shfl_xor(s, 32);
            if (lq == 0) (void)__hip_atomic_fetch_add(ss + row, s, __ATOMIC_RELAXED, __HIP_MEMORY_SCOPE_AGENT);
        }
        __syncthreads();
    }
}

#define XB_TMO      128
#define XB_XCNT(j)  (256  + 64 * (j))
#define XB_XSUB(j)  (1280 + 64 * (j))
#define XB_XGEN(j)  (2304 + 64 * (j))
#define XB_TOP      3328
#define XB_TOPGEN   3392
#define XCD_BAR_WORDS 3456
#define XB_SPIN_CAP (1u << 18)

__device__ __forceinline__ unsigned xb_ld(unsigned* p)              { return __hip_atomic_load(p, __ATOMIC_RELAXED, __HIP_MEMORY_SCOPE_AGENT); }
__device__ __forceinline__ unsigned xb_add(unsigned* p, unsigned v) { return __hip_atomic_fetch_add(p, v, __ATOMIC_RELAXED, __HIP_MEMORY_SCOPE_AGENT); }
__device__ __forceinline__ unsigned xb_xcc_id() { return (unsigned)__builtin_amdgcn_s_getreg((3 << 11) | 20) & 0xFu; }
#define XB_SPIN(cond, bar) do { unsigned _sp = 0; while (cond) { __builtin_amdgcn_s_sleep(1); \
    if ((++_sp & 255u) == 0u) { if (xb_ld(&(bar)[XB_TMO])) break; if (_sp > XB_SPIN_CAP) { atomicAdd(&(bar)[XB_TMO], 1u); break; } } } } while (0)

struct XcdBarrier {
    unsigned* bar; unsigned x;
    volatile LAS unsigned* st;
};

__device__ __forceinline__ XcdBarrier xcd_barrier_post(unsigned* bar, volatile LAS unsigned* st) {
    XcdBarrier b; b.bar = bar; b.x = xb_xcc_id(); b.st = st;
    if (threadIdx.x == 0) (void)xb_add(&bar[XB_XCNT(b.x)], 1u);
    return b;
}
__device__ __forceinline__ void xcd_barrier_complete(unsigned* bar, unsigned x, unsigned& nloc, unsigned& nx) {
    const unsigned G = gridDim.x * gridDim.y * gridDim.z;
    unsigned sum, cnt, mine, sp = 0u;
    for (;;) {
        sum = 0u; cnt = 0u; mine = 0u;
#pragma unroll
        for (unsigned j = 0; j < 16; ++j) { const unsigned c = xb_ld(&bar[XB_XCNT(j)]); sum += c; cnt += (c > 0u) ? 1u : 0u; mine = (j == x) ? c : mine; }
        if (sum == G) break;
        __builtin_amdgcn_s_sleep(1);
        if ((++sp & 255u) == 0u) { if (xb_ld(&bar[XB_TMO])) break; if (sp > XB_SPIN_CAP) { atomicAdd(&bar[XB_TMO], 1u); break; } }
    }
    nloc = mine > 0u ? mine : 1u; nx = cnt > 0u ? cnt : 1u;
}

__device__ __forceinline__ void xcd_barrier(const XcdBarrier& b) {
    asm volatile("s_waitcnt vmcnt(0)" ::: "memory");
    __syncthreads();
    if (threadIdx.x == 0) {
        unsigned* bar = b.bar;
        __builtin_amdgcn_s_waitcnt(0);
        unsigned nloc = b.st[0], nx = b.st[1];
        if (nloc == 0u) { xcd_barrier_complete(bar, b.x, nloc, nx); b.st[0] = nloc; b.st[1] = nx; }
        const unsigned old = xb_add(&bar[XB_XSUB(b.x)], 1u);
        const unsigned gen = old / nloc;
        if (old + 1u == (gen + 1u) * nloc) {
            __builtin_amdgcn_fence(__ATOMIC_RELEASE, "agent");
            asm volatile("s_waitcnt vmcnt(0)" ::: "memory");
            const unsigned og = xb_add(&bar[XB_TOP], 1u);
            const unsigned tg = og / nx;
            if (og + 1u == (tg + 1u) * nx) xb_add(&bar[XB_TOPGEN], 1u);
            else XB_SPIN(xb_ld(&bar[XB_TOPGEN]) == tg, bar);
            __builtin_amdgcn_fence(__ATOMIC_ACQUIRE, "agent");
            xb_add(&bar[XB_XGEN(b.x)], 1u);
            asm volatile("s_waitcnt vmcnt(0)" ::: "memory");
        } else {
            XB_SPIN(xb_ld(&bar[XB_XGEN(b.x)]) == gen, bar);
            __builtin_amdgcn_fence(__ATOMIC_ACQUIRE, "agent");
            asm volatile("s_waitcnt vmcnt(0)" ::: "memory");
        }
    }
    __syncthreads();
}

#ifndef REP_P0
#define REP_P0 1
#endif
#ifndef REP_ATT
#define REP_ATT 1
#endif
#ifndef REP_CONV
#define REP_CONV 1
#endif
#ifndef REP_P1
#define REP_P1 1
#endif
#ifndef REP_P2
#define REP_P2 1
#endif
#ifndef REP_P4
#define REP_P4 1
#endif
__global__ void __launch_bounds__(NTHREADS, 2) fwd_megakernel(Args A) {
    extern __shared__ __attribute__((aligned(16))) unsigned char lds_raw[];
    cg::grid_group grid = cg::this_grid();
    LAS unsigned char* lds = (LAS unsigned char*)lds_raw;
#define FRESH_TID() int tid_ = threadIdx.x; asm volatile("" : "+v"(tid_)); const int tid = tid_, lane = tid & 63, wave = __builtin_amdgcn_readfirstlane(tid >> 6); (void)lane; (void)wave;
    const int G = gridDim.x;
    unsigned char* ws = A.ws;
    volatile LAS unsigned* xst = (volatile LAS unsigned*)(lds + 131072);
    if (threadIdx.x < 4) xst[threadIdx.x] = 0u;
    __syncthreads();
    (void)xcd_barrier_post((unsigned*)(ws + WS_BAR), xst);
#define GRID_SYNC() do { { XcdBarrier xb_; xb_.bar = (unsigned*)(A.ws + WS_BAR); xb_.x = xb_xcc_id(); xb_.st = (volatile LAS unsigned*)(lds + 131072); xcd_barrier(xb_); } } while (0)
    float* stat = (float*)(ws + WS_STAT);
    bf16_t* XB = (bf16_t*)(ws + WS_XB);

    for (int rep = 0; rep < REP_P0; ++rep) { FRESH_TID(); p0_prologue(A, lds, tid, lane, wave); }
    if (A.use_cg) grid.sync();
    GRID_SYNC();

    for (int rep = 0; rep < REP_P1; ++rep) {
        pg8::Gemm g{XB, (const bf16_t*)(ws + WS_WQKV), MROWS, DIN, DM}; pg8::StaticOrder S; S.init(MROWS, DIN, G, (int)blockIdx.x);
        pg8::EpiQKV E{stat, (bf16_t*)(ws + WS_Q), (bf16_t*)(ws + WS_KP), (bf16_t*)(ws + WS_KS), (bf16_t*)(ws + WS_VT), (bf16_t*)(ws + WS_VTS), (bf16_t*)(ws + WS_U), (bf16_t*)(ws + WS_US), A.out};
        pg8::gemm_phase<pg8::EpiQKV, pg8::StaticOrder, true, true>(lds, g, S, E);
    }
    GRID_SYNC();

    for (int rep = 0; rep < REP_P2; ++rep) {
        FRESH_TID();
        LAS float* bt = (LAS float*)lds; LAS float* red = (LAS float*)(lds + 16384);
        for (int i = tid; i < 8 * 257; i += NTHREADS) bt[i] = A.rel_table[i] * LOG2E;
        __syncthreads();
        const bf16_t* Q = (const bf16_t*)(ws + WS_Q); const bf16_t* KP = (const bf16_t*)(ws + WS_KP); const bf16_t* KS = (const bf16_t*)(ws + WS_KS);
        const bf16_t* VT = (const bf16_t*)(ws + WS_VT); const bf16_t* VTS = (const bf16_t*)(ws + WS_VTS); bf16_t* OC = (bf16_t*)(ws + WS_OC);
        for (int rep2 = 0; rep2 < REP_ATT; ++rep2)
        for (int pc = blockIdx.x; pc < 256; pc += G) {
            const int b = pc >> 5, c = pc & 31, hd = wave;
            const long row0 = (long)b * TS + 64 * c;
            attn_unit<2>(Q + row0 * 512 + hd * 64, KP + (row0 - 512) * 512 + hd * 64, VT + ((long)b * 512 + hd * 64) * TS + 64 * c - 512, TS, (16 - 2 * c) > 0 ? (16 - 2 * c) : 0, 18,
                         bt + hd * 257, OC + row0 * 1024 + hd * 64, lane);
            if (c == 0) { const long rs = RP + b * 32; int lane2 = threadIdx.x & 63; asm volatile("" : "+v"(lane2)); const int lane = lane2;
                attn_unit<1>(Q + rs * 512 + hd * 64, KS + (long)b * 544 * 512 + hd * 64, VTS + ((long)b * 512 + hd * 64) * 544, 544, 0, 17, bt + hd * 257, OC + rs * 1024 + hd * 64, lane); }
        }
        __syncthreads();
        int tid2 = threadIdx.x; asm volatile("" : "+v"(tid2));
        for (int rep2 = 0; rep2 < REP_CONV; ++rep2)
        for (int u = blockIdx.x; u < 1040; u += G) {
            const int tid = tid2, lane = tid2 & 63;
            const bool smp = u >= 1024; const int b = smp ? (u - 1024) >> 1 : u >> 7, t0 = smp ? ((u - 1024) & 1) * 16 : (u & 127) * 16;
            const bf16_t* ub = smp ? (const bf16_t*)(ws + WS_US) + ((size_t)b * 62 + 30) * 512 : (const bf16_t*)(ws + WS_U) + (size_t)b * TS * 512;
            conv_unit(A, ub, smp ? -30 : 0, t0, OC + (size_t)(smp ? RP + b * 32 : b * TS) * 1024 + 512, red, tid, lane, wave);
        }
    }
    GRID_SYNC();

    {
        pg8::Gemm g{(const bf16_t*)(ws + WS_OC), (const bf16_t*)(ws + WS_WO), RP, DM, DM}; pg8::StaticOrder S; S.init(RP, DM, G, (int)blockIdx.x);
        pg8::EpiRes<true> E{A.x_prompt, A.x_sample, A.out, XB, stat + MROWS};
        pg8::gemm_phase<pg8::EpiRes<true>, pg8::StaticOrder, true, true>(lds, g, S, E);
        sample_gemm<true>((const bf16_t*)(ws + WS_OC) + (size_t)RP * DM, (const bf16_t*)(ws + WS_WO), DM, A.x_sample, A.out + (size_t)RP * DM, XB + (size_t)RP * DM, stat + MROWS + RP, lds);
    }
    GRID_SYNC();

    for (int rep = 0; rep < REP_P4; ++rep) {
        pg8::Gemm g{XB, (const bf16_t*)(ws + WS_WGU), MROWS, NGU, DM}; pg8::StaticOrder S; S.init(MROWS, NGU, G, (int)blockIdx.x);
        pg8::EpiGU E{stat + MROWS, (bf16_t*)(ws + WS_HM)};
        pg8::gemm_phase<pg8::EpiGU, pg8::StaticOrder, true, true>(lds, g, S, E);
    }
    GRID_SYNC();

    {
        pg8::Gemm g{(const bf16_t*)(ws + WS_HM), (const bf16_t*)(ws + WS_WD), RP, DM, DFF}; pg8::StaticOrder S; S.init(RP, DM, G, (int)blockIdx.x);
        pg8::EpiRes<false> E{A.out, A.out + (size_t)RP * DM, A.out, nullptr, stat + 2 * MROWS};
        pg8::gemm_phase<pg8::EpiRes<false>, pg8::StaticOrder, true, true>(lds, g, S, E);
        sample_gemm<false>((const bf16_t*)(ws + WS_HM) + (size_t)RP * DFF, (const bf16_t*)(ws + WS_WD), DFF, A.out + (size_t)RP * DM, A.out + (size_t)RP * DM, nullptr, stat + 2 * MROWS + RP, lds);
    }
    GRID_SYNC();

    {
        FRESH_TID();
        const int gw = blockIdx.x * NWAVES + wave, NGW = G * NWAVES;
        f32x4 gf[4];
#pragma unroll
        for (int j = 0; j < 4; ++j) gf[j] = ((const f32x4*)A.g_final)[lane + 64 * j];
        for (int m = gw; m < MROWS; m += NGW) {
            f32x4* row = (f32x4*)(A.out + (size_t)m * DM);
            const float rs = __builtin_amdgcn_rsqf(stat[2 * MROWS + m] * (1.0f / DM) + 1e-6f);
#pragma unroll
            for (int j = 0; j < 4; ++j) row[lane + 64 * j] = row[lane + 64 * j] * rs * gf[j];
        }
    }
}

extern "C" void kernel_launch(void* const* d_in, const int* in_sizes, int n_in, void* d_out, int out_size, void* d_ws, size_t ws_size, hipStream_t stream) {
    static int grid = 0;
    if (grid == 0) {
        int dev = 0, cus = 0, per_cu = 0;
        hipGetDevice(&dev);
        hipDeviceGetAttribute(&cus, hipDeviceAttributeMultiprocessorCount, dev);
        if (hipFuncSetAttribute((const void*)fwd_megakernel, hipFuncAttributeMaxDynamicSharedMemorySize, LDS_BYTES) != hipSuccess) { fprintf(stderr, "hipFuncSetAttribute failed\n"); }
        hipOccupancyMaxActiveBlocksPerMultiprocessor(&per_cu, (const void*)fwd_megakernel, NTHREADS, LDS_BYTES);
        (void)hipGetLastError();
        if (per_cu < 1) per_cu = 1;
        grid = cus * per_cu;
    }
    Args a{};
    a.x_prompt = (const float*)d_in[0]; a.x_sample = (const float*)d_in[1]; a.cache_k = (const float*)d_in[2]; a.cache_v = (const float*)d_in[3]; a.state_conv = (const float*)d_in[4];
    a.g_mix = (const float*)d_in[5]; a.w_in = (const float*)d_in[6]; a.rel_table = (const float*)d_in[7]; a.w_dw = (const float*)d_in[8]; a.b_dw = (const float*)d_in[9];
    a.ln_g = (const float*)d_in[10]; a.ln_b = (const float*)d_in[11]; a.w_out = (const float*)d_in[12]; a.g_ffn = (const float*)d_in[13]; a.w_gate = (const float*)d_in[14];
    a.w_up = (const float*)d_in[15]; a.w_down = (const float*)d_in[16]; a.g_final = (const float*)d_in[17];
    a.out = (float*)d_out; a.ws = (unsigned char*)d_ws;
    a.use_cg = 0; a.pad = 0;
    (void)hipMemsetAsync((unsigned char*)d_ws + WS_BAR, 0, XCD_BAR_WORDS * 4, stream);
    void* args[] = {&a};
    hipError_t e = hipLaunchCooperativeKernel((const void*)fwd_megakernel, dim3(grid), dim3(NTHREADS), args, LDS_BYTES, stream);
    if (e != hipSuccess) fprintf(stderr, "cooperative launch failed: %s (grid %d)\n", hipGetErrorString(e), grid);
}
```

```cpp
#include <hip/hip_runtime.h>
#include <hip/hip_cooperative_groups.h>
#include <cstdio>
#include <cstdint>
namespace cg = cooperative_groups;
namespace pg8 {
#define PG8_LAS __attribute__((address_space(3)))
typedef unsigned short bf16_t;
typedef short bf16x8 __attribute__((ext_vector_type(8)));
typedef float f32x4 __attribute__((ext_vector_type(4)));
typedef unsigned u32x4 __attribute__((ext_vector_type(4)));
constexpr int BM = 256, BK = 64, HALF = 128, HTB = HALF * BK * 2  , STAGE_BYTES = 8 * HTB, NXCD = 8, WGM = 8;

__host__ __device__ __forceinline__ int lds_byte(int r, int c) { const int st = (r >> 4) * 2 + (c >> 5), rr = r & 15, cc = c & 31, ob = rr * 64 + cc * 2; return st * 1024 + (ob ^ (((ob >> 9) & 1) << 5)); }
__host__ __device__ __forceinline__ void stage_rc(int b, int& R, int& C) { const int st = b / 1024, sb = b % 1024, swz = sb ^ (((sb >> 9) & 1) << 5); R = (st >> 1) * 16 + swz / 64; C = (st & 1) * 32 + (swz % 64) / 2; }
__host__ __device__ __forceinline__ int perm32(int rho) { const int n = rho >> 4, i = rho & 15; return 8 * (i >> 2) + 4 * n + (i & 3); }

struct Unit { int pm, pn; };
struct Gemm { const bf16_t* A; const bf16_t* Bt; int M, N, K; };

struct StaticOrder {
    int nM, nN, nwg, G, c;
    __host__ __device__ void init(int M, int N, int G_, int c_) { nM = M / BM; nN = N / BM; nwg = nM * nN; G = G_; c = c_; }
    __host__ __device__ bool next(int i, Unit& u) const {
        const long L = (long)i * G + c; if (L >= nwg) return false;
        int wgid = (int)L; { const int q = nwg / NXCD, r = nwg % NXCD, xcd = wgid % NXCD, off = wgid / NXCD; wgid = (xcd < r ? xcd * (q + 1) : r * (q + 1) + (xcd - r) * q) + off; }
        const int nig = WGM * nN, gid = wgid / nig, fm = gid * WGM, gsz = (nM - fm) < WGM ? (nM - fm) : WGM;
        u.pm = fm + ((wgid % nig) % gsz); u.pn = (wgid % nig) / gsz; return true;
    }
    __device__ __forceinline__ void a_ready(const Unit&) const {}
    __device__ __forceinline__ void done(const Unit&) const {}
};

__device__ __forceinline__ unsigned cvt_pk_bf16(float lo, float hi) { unsigned r; asm volatile("v_cvt_pk_bf16_f32 %0, %1, %2" : "=v"(r) : "v"(lo), "v"(hi)); return r; }
typedef float f32x2 __attribute__((ext_vector_type(2)));

constexpr int R_PROMPT = 16384, T_SEQ = 2048;
constexpr size_t OFF_Y = 0, OFF_KP = 17039360, OFF_VP = 19136512, OFF_CP = 21233664, OFF_KS = 21356544, OFF_VS = 23453696, OFF_CS = 25550848;

__device__ __forceinline__ u32x4 pack8(const f32x4 a, const f32x4 b) { u32x4 w; w.x = cvt_pk_bf16(a[0], a[1]); w.y = cvt_pk_bf16(a[2], a[3]); w.z = cvt_pk_bf16(b[0], b[1]); w.w = cvt_pk_bf16(b[2], b[3]); return w; }
__device__ __forceinline__ float fast_sigmoid(float g) { return __builtin_amdgcn_rcpf(1.0f + __builtin_amdgcn_exp2f(-1.4426950408889634f * g)); }

struct EpiQKV {
    static constexpr bool PERM = true, AFTER_DRAIN = false;
    const float* rstd0; bf16_t* Q; bf16_t* KP; bf16_t* KS; bf16_t* VT; bf16_t* VTS; bf16_t* U; bf16_t* US; float* out;
    __device__ __forceinline__ void operator()(const f32x4 (&acc)[2][2][4][2], const Unit& u, int wr, int wc, int fr, int fq) const {
        asm volatile("" : "+v"(fr), "+v"(fq));
        const int rbase = u.pm * BM + wr * 64 + fr;
        const bool sample = (u.pm == 64);
        const int kind = u.pn >> 1;
        const int b = sample ? 0 : (u.pm >> 3);
        if (kind == 0) {
            const int col0 = u.pn * BM + wc * 32 + 8 * fq;
#pragma unroll
            for (int ai = 0; ai < 2; ++ai)
#pragma unroll
                for (int m = 0; m < 4; ++m) { const int r = rbase + ai * HALF + m * 16; const float rs = rstd0[r];
#pragma unroll
                    for (int bj = 0; bj < 2; ++bj) *(u32x4*)(Q + (size_t)r * 512 + col0 + bj * HALF) = pack8(acc[ai][bj][m][0] * rs, acc[ai][bj][m][1] * rs); }
        } else if (kind == 1 || kind == 2) {
            const int col0 = (u.pn & 1) * BM + wc * 32 + 8 * fq;
            const bool isv = (kind == 2);
            const bool keep = sample || ((u.pm & 7) >= 6);
            float* ofp = out + (sample ? (isv ? OFF_VS : OFF_KS) : (isv ? OFF_VP : OFF_KP));
#pragma unroll
            for (int ai = 0; ai < 2; ++ai)
#pragma unroll
                for (int m = 0; m < 4; ++m) { const int r = rbase + ai * HALF + m * 16; const float rs = rstd0[r];
                    int sb, st, orow;
                    if (sample) { const int rr = r - R_PROMPT; sb = rr >> 5; st = 512 + (rr & 31); orow = sb * 512 + 480 + (rr & 31); }
                    else { sb = b; st = r - b * T_SEQ; orow = b * 512 + st - 1536; }
#pragma unroll
                    for (int bj = 0; bj < 2; ++bj) { const f32x4 v0 = acc[ai][bj][m][0] * rs, v1 = acc[ai][bj][m][1] * rs; const int c = col0 + bj * HALF;
                        if (keep) { *(f32x4*)(ofp + (size_t)orow * 512 + c) = v0; *(f32x4*)(ofp + (size_t)orow * 512 + c + 4) = v1; }
                        const u32x4 w = pack8(v0, v1);
                        if (!isv) { bf16_t* kd = sample ? KS + ((size_t)sb * 544 + st) * 512 : KP + (size_t)r * 512; *(u32x4*)(kd + c) = w; }
                        else { bf16_t* vd = sample ? VTS + ((size_t)sb * 512 + c) * 544 + st : VT + ((size_t)sb * 512 + c) * T_SEQ + st; const int vp = sample ? 544 : T_SEQ;
                            vd[0] = (bf16_t)(w.x & 0xffffu); vd[vp] = (bf16_t)(w.x >> 16); vd[2 * vp] = (bf16_t)(w.y & 0xffffu); vd[3 * vp] = (bf16_t)(w.y >> 16);
                            vd[4 * vp] = (bf16_t)(w.z & 0xffffu); vd[5 * vp] = (bf16_t)(w.z >> 16); vd[6 * vp] = (bf16_t)(w.w & 0xffffu); vd[7 * vp] = (bf16_t)(w.w >> 16); } } }
        } else {
            const int ch0 = (u.pn - 6) * HALF + wc * 32 + 8 * fq;
            const bool tail = sample || ((u.pm & 7) == 7);
#pragma unroll
            for (int ai = 0; ai < 2; ++ai)
#pragma unroll
                for (int m = 0; m < 4; ++m) { const int r = rbase + ai * HALF + m * 16; const float rs = rstd0[r];
                    f32x4 v[2];
#pragma unroll
                    for (int n = 0; n < 2; ++n) { const f32x4 a = acc[ai][0][m][n] * rs, g = acc[ai][1][m][n] * rs;
                        v[n] = (f32x4){a[0] * fast_sigmoid(g[0]), a[1] * fast_sigmoid(g[1]), a[2] * fast_sigmoid(g[2]), a[3] * fast_sigmoid(g[3])}; }
                    { bf16_t* ud = sample ? US + ((size_t)((r - R_PROMPT) >> 5) * 62 + 30 + ((r - R_PROMPT) & 31)) * 512 : U + (size_t)r * 512; *(u32x4*)(ud + ch0) = pack8(v[0], v[1]); }
                    if (tail) { int orow = -1;
                        if (sample) { const int rr = r - R_PROMPT; if ((rr & 31) >= 2) orow = (rr >> 5) * 30 + (rr & 31) - 2; }
                        else { const int st = r - b * T_SEQ; if (st >= T_SEQ - 30) orow = b * 30 + st - (T_SEQ - 30); }
                        if (orow >= 0) { float* o = out + (sample ? OFF_CS : OFF_CP) + (size_t)orow * 512 + ch0; *(f32x4*)o = v[0]; *(f32x4*)(o + 4) = v[1]; } } }
        }
    }
};

template <bool BF> struct EpiRes {
    static constexpr bool PERM = true, AFTER_DRAIN = false;
    const float* basep; const float* bases; float* outf; bf16_t* outb; float* ss;
    __device__ __forceinline__ void operator()(const f32x4 (&acc)[2][2][4][2], const Unit& u, int wr, int wc, int fr, int fq) const {
        asm volatile("" : "+v"(fr), "+v"(fq));
        const int rbase = u.pm * BM + wr * 64 + fr; const int col0 = u.pn * BM + wc * 32 + 8 * fq;
        const float* bp = (u.pm == 64) ? bases - (size_t)R_PROMPT * 1024 : basep;
#pragma unroll
        for (int ai = 0; ai < 2; ++ai)
#pragma unroll
            for (int m = 0; m < 4; ++m) { const int r = rbase + ai * HALF + m * 16; const size_t off = (size_t)r * 1024 + col0; float s = 0.f;
#pragma unroll
                for (int bj = 0; bj < 2; ++bj) { const f32x4 xa = *(const f32x4*)(bp + off + bj * HALF), xb = *(const f32x4*)(bp + off + bj * HALF + 4);
                    const f32x4 v0 = acc[ai][bj][m][0] + xa, v1 = acc[ai][bj][m][1] + xb;
                    *(f32x4*)(outf + off + bj * HALF) = v0; *(f32x4*)(outf + off + bj * HALF + 4) = v1;
                    if (BF) *(u32x4*)(outb + off + bj * HALF) = pack8(v0, v1);
                    s += (v0[0] * v0[0] + v0[1] * v0[1]) + (v0[2] * v0[2] + v0[3] * v0[3]) + (v1[0] * v1[0] + v1[1] * v1[1]) + (v1[2] * v1[2] + v1[3] * v1[3]); }
                s += __shfl_xor(s, 16); s += __shfl_xor(s, 32);
                if (fq == 0) (void)__hip_atomic_fetch_add(ss + r, s, __ATOMIC_RELAXED, __HIP_MEMORY_SCOPE_AGENT); }
    }
};

struct EpiGU {
    static constexpr bool PERM = true, AFTER_DRAIN = false;
    const float* ss1; bf16_t* HM;
    __device__ __forceinline__ void operator()(const f32x4 (&acc)[2][2][4][2], const Unit& u, int wr, int wc, int fr, int fq) const {
        asm volatile("" : "+v"(fr), "+v"(fq));
        const int rbase = u.pm * BM + wr * 64 + fr; const int ch0 = u.pn * HALF + wc * 32 + 8 * fq;
#pragma unroll
        for (int ai = 0; ai < 2; ++ai)
#pragma unroll
            for (int m = 0; m < 4; ++m) { const int r = rbase + ai * HALF + m * 16; const float rs = __builtin_amdgcn_rsqf(ss1[r] * (1.0f / 1024.0f) + 1e-6f);
                f32x4 v[2];
#pragma unroll
                for (int n = 0; n < 2; ++n) { const f32x4 g = acc[ai][0][m][n] * rs, up = acc[ai][1][m][n] * rs;
                    v[n] = (f32x4){g[0] * fast_sigmoid(g[0]) * up[0], g[1] * fast_sigmoid(g[1]) * up[1], g[2] * fast_sigmoid(g[2]) * up[2], g[3] * fast_sigmoid(g[3]) * up[3]}; }
                *(u32x4*)(HM + (size_t)r * 2816 + ch0) = pack8(v[0], v[1]); }
    }
};
template <class Epi, class Sched, bool ALIGN_EPI = false, bool SP2 = false>
__device__ __forceinline__ void gemm_phase(PG8_LAS unsigned char* lds, const Gemm g, const Sched& S, const Epi& E) {
    int tid_ = threadIdx.x; asm volatile("" : "+v"(tid_)); const int tid = tid_, wid = __builtin_amdgcn_readfirstlane(tid >> 6), lane = tid & 63, wr = wid >> 2, wc = wid & 3, fr = lane & 15, fq = lane >> 4;
    const int K = g.K, nt = K / BK;
    unsigned voffA[2], voffB[2];
#pragma unroll
    for (int i = 0; i < 2; ++i) { int R, C; stage_rc(tid * 16 + i * 8192, R, C); const int Rb = Epi::PERM ? ((R & ~31) + perm32(R & 31)) : R;
        voffA[i] = (unsigned)(R * K + C) * 2u; voffB[i] = (unsigned)(Rb * K + C) * 2u; }
    const size_t kstep = (size_t)(BK * 2);
    const size_t hstep = (size_t)HALF * K * 2;
    const size_t tstep = 2 * hstep;
    const unsigned ldsw = (unsigned)wid * 1024u;
    const int aoff = lds_byte(wr * 64 + fr, fq * 8), boff = lds_byte(wc * 32 + fr, fq * 8);
#define PG8_SA(b, h) (((b) * 2 + (h)) * HTB)
#define PG8_SB(b, h) ((4 + (b) * 2 + (h)) * HTB)
#define PG8_STAGE(bufoff, gbase, voff) do { _Pragma("unroll") for (int _i = 0; _i < 2; ++_i) \
        __builtin_amdgcn_global_load_lds((const unsigned*)((const char*)(gbase) + (voff)[_i]), (PG8_LAS unsigned*)(lds + (bufoff) + ldsw + _i * 8192), 16, 0, 0); } while (0)
#define PG8_LDA(dst, b, h) do { _Pragma("unroll") for (int m = 0; m < 4; ++m) _Pragma("unroll") for (int k = 0; k < 2; ++k) dst[m][k] = *(const PG8_LAS bf16x8*)(lds + PG8_SA(b, h) + aoff + m * 2048 + k * 1024); } while (0)
#define PG8_LDB(dst, b, h) do { _Pragma("unroll") for (int n = 0; n < 2; ++n) _Pragma("unroll") for (int k = 0; k < 2; ++k) dst[n][k] = *(const PG8_LAS bf16x8*)(lds + PG8_SB(b, h) + boff + n * 2048 + k * 1024); } while (0)
#define PG8_MMA(ai, bj, At, Bt) do { __builtin_amdgcn_s_setprio(1); _Pragma("unroll") for (int m = 0; m < 4; ++m) _Pragma("unroll") for (int n = 0; n < 2; ++n) _Pragma("unroll") for (int k = 0; k < 2; ++k) \
        acc[ai][bj][m][n] = __builtin_amdgcn_mfma_f32_16x16x32_bf16(Bt[n][k], At[m][k], acc[ai][bj][m][n], 0, 0, 0); __builtin_amdgcn_s_setprio(0); } while (0)
#define PG8_WAIT_V(n) asm volatile("s_waitcnt vmcnt(" #n ")" ::: "memory")
#define PG8_WAIT_L(n) asm volatile("s_waitcnt lgkmcnt(" #n ")" ::: "memory")
#define PG8_BAR __builtin_amdgcn_s_barrier()
#define PG8_SCHED __builtin_amdgcn_sched_barrier(0)
    Unit cur, nxt; int ui = 0;
    if (!S.next(0, cur)) return;
    f32x4 acc[2][2][4][2];
#pragma unroll
    for (int a = 0; a < 2; ++a)
#pragma unroll
        for (int b = 0; b < 2; ++b)
#pragma unroll
            for (int m = 0; m < 4; ++m)
#pragma unroll
                for (int n = 0; n < 2; ++n) acc[a][b][m][n] = (f32x4){0.f, 0.f, 0.f, 0.f};
    bf16x8 At[4][2], B0[2][2], B1[2][2];
    const char* cA = (const char*)g.A + (size_t)cur.pm * tstep; const char* cB = (const char*)g.Bt + (size_t)cur.pn * tstep;
    S.a_ready(cur);
    if constexpr (SP2) {
        PG8_STAGE(PG8_SB(0, 0), cB, voffB); PG8_STAGE(PG8_SB(0, 1), cB + hstep, voffB); PG8_STAGE(PG8_SA(0, 0), cA, voffA); PG8_STAGE(PG8_SA(0, 1), cA + hstep, voffA);
        if (wr == 1) PG8_BAR;
        PG8_WAIT_V(2); PG8_BAR;
        PG8_STAGE(PG8_SB(1, 0), cB + kstep, voffB); PG8_STAGE(PG8_SA(1, 0), cA + kstep, voffA); PG8_STAGE(PG8_SB(1, 1), cB + hstep + kstep, voffB);
        PG8_WAIT_V(6); PG8_BAR;
    } else {
        PG8_STAGE(PG8_SB(0, 0), cB, voffB); PG8_STAGE(PG8_SA(0, 0), cA, voffA); PG8_STAGE(PG8_SB(0, 1), cB + hstep, voffB); PG8_STAGE(PG8_SA(0, 1), cA + hstep, voffA);
        if (wr == 1) PG8_BAR;
        PG8_WAIT_V(4); PG8_BAR;
        PG8_STAGE(PG8_SB(1, 0), cB + kstep, voffB); PG8_STAGE(PG8_SA(1, 0), cA + kstep, voffA); PG8_STAGE(PG8_SB(1, 1), cB + hstep + kstep, voffB);
        PG8_WAIT_V(6); PG8_BAR;
    }
    for (;;) {
        const bool has_next = S.next(ui + 1, nxt);
        const char* nA = has_next ? (const char*)g.A + (size_t)nxt.pm * tstep : cA; const char* nB = has_next ? (const char*)g.Bt + (size_t)nxt.pn * tstep : cB;
        for (int t = 0; t < nt; t += 2) {
            const bool last = (t == nt - 2);
            const char* a1 = cA + (size_t)(t + 1) * kstep;
            const char* a2 = last ? nA : cA + (size_t)(t + 2) * kstep; const char* b2 = last ? nB : cB + (size_t)(t + 2) * kstep;
            const char* a3 = a2 + kstep; const char* b3 = b2 + kstep;
            if (last && has_next) S.a_ready(nxt);
            if constexpr (SP2) {
            PG8_LDB(B0, 0, 0); PG8_LDB(B1, 0, 1); PG8_SCHED; PG8_LDA(At, 0, 0); PG8_STAGE(PG8_SA(1, 1), a1 + hstep, voffA);
            PG8_WAIT_V(8); PG8_WAIT_L(0); PG8_BAR; PG8_MMA(0, 0, At, B0); PG8_MMA(0, 1, At, B1); PG8_BAR; PG8_SCHED;
            PG8_LDA(At, 0, 1); PG8_STAGE(PG8_SB(0, 0), b2, voffB); PG8_STAGE(PG8_SB(0, 1), b2 + hstep, voffB); PG8_STAGE(PG8_SA(0, 0), a2, voffA);
            PG8_WAIT_V(8); PG8_WAIT_L(0); PG8_BAR; PG8_MMA(1, 0, At, B0); PG8_MMA(1, 1, At, B1); PG8_BAR; PG8_SCHED;
            PG8_LDB(B0, 1, 0); PG8_LDB(B1, 1, 1); PG8_SCHED; PG8_LDA(At, 1, 0); PG8_STAGE(PG8_SA(0, 1), a2 + hstep, voffA);
            PG8_WAIT_V(8); PG8_WAIT_L(0); PG8_BAR; PG8_MMA(0, 0, At, B0); PG8_MMA(0, 1, At, B1); PG8_BAR; PG8_SCHED;
            PG8_LDA(At, 1, 1); PG8_STAGE(PG8_SB(1, 0), b3, voffB); PG8_STAGE(PG8_SB(1, 1), b3 + hstep, voffB); PG8_STAGE(PG8_SA(1, 0), a3, voffA);
            PG8_WAIT_V(8); PG8_WAIT_L(0); PG8_BAR; PG8_MMA(1, 0, At, B0); PG8_MMA(1, 1, At, B1); PG8_BAR; PG8_SCHED;
            } else {
            PG8_LDB(B0, 0, 0); PG8_SCHED; PG8_LDA(At, 0, 0); PG8_STAGE(PG8_SA(1, 1), a1 + hstep, voffA);
            PG8_WAIT_L(8); PG8_BAR; PG8_WAIT_L(0); PG8_MMA(0, 0, At, B0); PG8_BAR; PG8_SCHED;
            PG8_LDB(B1, 0, 1); PG8_STAGE(PG8_SB(0, 0), b2, voffB);
            PG8_BAR; PG8_WAIT_L(0); PG8_MMA(0, 1, At, B1); PG8_BAR;
            PG8_LDA(At, 0, 1); PG8_STAGE(PG8_SA(0, 0), a2, voffA);
            PG8_BAR; PG8_WAIT_L(0); PG8_MMA(1, 0, At, B0); PG8_BAR; PG8_SCHED;
            PG8_STAGE(PG8_SB(0, 1), b2 + hstep, voffB);
            PG8_WAIT_V(6); PG8_BAR; PG8_MMA(1, 1, At, B1); PG8_BAR;
            PG8_LDB(B0, 1, 0); PG8_SCHED; PG8_LDA(At, 1, 0); PG8_STAGE(PG8_SA(0, 1), a2 + hstep, voffA);
            PG8_WAIT_L(8); PG8_BAR; PG8_WAIT_L(0); PG8_MMA(0, 0, At, B0); PG8_BAR; PG8_SCHED;
            PG8_LDB(B1, 1, 1); PG8_STAGE(PG8_SB(1, 0), b3, voffB);
            PG8_BAR; PG8_WAIT_L(0); PG8_MMA(0, 1, At, B1); PG8_BAR;
            PG8_LDA(At, 1, 1); PG8_STAGE(PG8_SA(1, 0), a3, voffA);
            PG8_BAR; PG8_WAIT_L(0); PG8_MMA(1, 0, At, B0); PG8_BAR; PG8_SCHED;
            PG8_STAGE(PG8_SB(1, 1), b3 + hstep, voffB);
            PG8_WAIT_V(6); PG8_BAR; PG8_MMA(1, 1, At, B1); PG8_BAR;
            }
        }
        if constexpr (ALIGN_EPI) { if (wr == 0) PG8_BAR; }
        if constexpr (!Epi::AFTER_DRAIN) { E(acc, cur, wr, wc, fr, fq); S.done(cur); }
        if (!has_next) break;
#pragma unroll
        for (int a = 0; a < 2; ++a)
#pragma unroll
            for (int b = 0; b < 2; ++b)
#pragma unroll
                for (int m = 0; m < 4; ++m)
#pragma unroll
                    for (int n = 0; n < 2; ++n) acc[a][b][m][n] = (f32x4){0.f, 0.f, 0.f, 0.f};
        cur = nxt; cA = nA; cB = nB; ++ui;
        if constexpr (ALIGN_EPI) { if (wr == 1) PG8_BAR; }
    }
    PG8_WAIT_V(0);
    if constexpr (!ALIGN_EPI) { if (wr == 0) PG8_BAR; }
    PG8_BAR;
    if constexpr (Epi::AFTER_DRAIN) { E.fused(acc, cur, wr, wc, fr, fq, lds, wid, lane); S.done(cur); }
#undef PG8_SA
#undef PG8_SB
#undef PG8_STAGE
#undef PG8_LDA
#undef PG8_LDB
#undef PG8_MMA
#undef PG8_WAIT_V
#undef PG8_WAIT_L
#undef PG8_BAR
#undef PG8_SCHED
}
}

#define LAS __attribute__((address_space(3)))
using namespace pg8;
typedef unsigned u32x2 __attribute__((ext_vector_type(2)));
typedef float f32x16 __attribute__((ext_vector_type(16)));

constexpr int NWAVES = 8, NTHREADS = 512;
constexpr int DM = 1024, MROWS = 16640, RP = 16384, TS = 2048, DIN = 2560, DFF = 2816, NGU = 5632;
constexpr int LDS_BYTES = 139264;
constexpr float LOG2E = 1.4426950408889634f;

constexpr size_t MiB = 1u << 20;
constexpr size_t WS_STAT = 0;
constexpr size_t WS_BAR = 512 * 1024;
constexpr size_t WS_WQKV = 1 * MiB;
constexpr size_t WS_WO = 7 * MiB;
constexpr size_t WS_WGU = 9 * MiB;
constexpr size_t WS_WD = 21 * MiB;
constexpr size_t WS_XB = 27 * MiB;
constexpr size_t WS_Q = 60 * MiB;
constexpr size_t WS_KP = 77 * MiB;
constexpr size_t WS_KS = 93 * MiB;
constexpr size_t WS_VT = 98 * MiB;
constexpr size_t WS_VTS = 114 * MiB;
constexpr size_t WS_U = 119 * MiB;
constexpr size_t WS_US = 135 * MiB + 512 * 1024;
constexpr size_t WS_OC = 136 * MiB;
constexpr size_t WS_HM = 60 * MiB;
static_assert(WS_HM + (size_t)MROWS * DFF * 2 <= 169 * MiB, "ws map");

struct Args {
    const float *x_prompt, *x_sample, *cache_k, *cache_v, *state_conv, *g_mix, *w_in, *rel_table, *w_dw, *b_dw, *ln_g, *ln_b, *w_out, *g_ffn, *w_gate, *w_up, *w_down, *g_final;
    float* out; unsigned char* ws; int use_cg; int pad;
};

__device__ __forceinline__ unsigned cvtpk(float lo, float hi) { unsigned r; asm volatile("v_cvt_pk_bf16_f32 %0, %1, %2" : "=v"(r) : "v"(lo), "v"(hi)); return r; }
__device__ __forceinline__ float wave_sum(float v) {
#pragma unroll
    for (int o = 1; o < 64; o <<= 1) v += __shfl_xor(v, o);
    return v;
}
#define LDS_WAIT() asm volatile("s_waitcnt lgkmcnt(0)" ::: "memory")

__device__ __forceinline__ void transpose_item(const float* W, int ldw, int srccol0, int k0, bf16_t* WT, int ldt, int dstrow0, const float* gs, LAS float* scr, int lane) {
    float tv[32];
#pragma unroll
    for (int i = 0; i < 32; ++i) { const int kk = 2 * i + (lane >> 5); tv[i] = W[(size_t)(k0 + kk) * ldw + srccol0 + (lane & 31)]; }
    if (gs) {
#pragma unroll
        for (int i = 0; i < 32; ++i) tv[i] *= gs[k0 + 2 * i + (lane >> 5)]; }
#pragma unroll
    for (int i = 0; i < 32; ++i) { const int kk = 2 * i + (lane >> 5); scr[kk * 33 + (lane & 31)] = tv[i]; }
    LDS_WAIT(); asm volatile("" ::: "memory");
    const int c = lane & 7;
#pragma unroll
    for (int j = 0; j < 4; ++j) { const int n = (lane >> 3) + 8 * j; const LAS float* s = scr + (8 * c) * 33 + n;
        u32x4 o; o.x = cvtpk(s[0 * 33], s[1 * 33]); o.y = cvtpk(s[2 * 33], s[3 * 33]); o.z = cvtpk(s[4 * 33], s[5 * 33]); o.w = cvtpk(s[6 * 33], s[7 * 33]);
        *(u32x4*)(WT + (size_t)(dstrow0 + n) * ldt + k0 + 8 * c) = o; }
    LDS_WAIT(); asm volatile("" ::: "memory");
}

__device__ __forceinline__ void p0_prologue(const Args& A, LAS unsigned char* lds, int tid, int lane, int wave) {
    unsigned char* ws = A.ws;
    LAS float* scr = (LAS float*)(lds + wave * 16384);
    const int G = gridDim.x, gw = blockIdx.x * NWAVES + wave, NGW = G * NWAVES;
    float* stat = (float*)(ws + WS_STAT);
    for (int i = blockIdx.x * NTHREADS + tid; i < 2 * MROWS; i += G * NTHREADS) stat[MROWS + i] = 0.f;
    constexpr int I_A = 16 * 80, I_B = 16 * 32, I_C = 16 * 176, I_D = 44 * 32, I_E = 8 * 128;
    constexpr int NITEMS = I_A + I_B + I_C + I_D + I_E;
    for (int it = gw; it < NITEMS; it += NGW) {
        int r = it;
        if (r < I_A) { const int kb = r / 80, nb = r % 80, d0 = 32 * nb; int sc = d0;
            if (d0 >= 1536) { const int j = d0 - 1536, t = j >> 8, jj = j & 255; sc = (jj < 128) ? 1536 + 128 * t + jj : 2048 + 128 * t + (jj - 128); }
            transpose_item(A.w_in, DIN, sc, 64 * kb, (bf16_t*)(ws + WS_WQKV), DM, d0, A.g_mix, scr, lane); continue; } r -= I_A;
        if (r < I_B) { const int kb = r / 32, nb = r % 32; transpose_item(A.w_out, DM, 32 * nb, 64 * kb, (bf16_t*)(ws + WS_WO), DM, 32 * nb, nullptr, scr, lane); continue; } r -= I_B;
        if (r < I_C) { const int kb = r / 176, nb = r % 176, d0 = 32 * nb, t = d0 >> 8, jj = d0 & 255;
            transpose_item(jj < 128 ? A.w_gate : A.w_up, DFF, 128 * t + (jj & 127), 64 * kb, (bf16_t*)(ws + WS_WGU), DM, d0, A.g_ffn, scr, lane); continue; } r -= I_C;
        if (r < I_D) { const int kb = r / 32, nb = r % 32; transpose_item(A.w_down, DM, 32 * nb, 64 * kb, (bf16_t*)(ws + WS_WD), DFF, 32 * nb, nullptr, scr, lane); continue; } r -= I_D;
        { const int b = r >> 7, q = r & 127, kb = q >> 4, nb = q & 15;
          transpose_item(A.cache_v + (size_t)b * 512 * 512, 512, 32 * nb, 64 * kb, (bf16_t*)(ws + WS_VTS) + (size_t)b * 512 * 544, 544, 32 * nb, nullptr, scr, lane); }
    }
    bf16_t* XB = (bf16_t*)(ws + WS_XB);
    for (int m0 = gw * 4; m0 < MROWS; m0 += NGW * 4) {
        f32x4 v[4][4];
#pragma unroll
        for (int q = 0; q < 4; ++q) { const int m = m0 + q; const float* xr = (m < RP) ? A.x_prompt + (size_t)m * DM : A.x_sample + (size_t)(m - RP) * DM;
#pragma unroll
            for (int j = 0; j < 4; ++j) v[q][j] = ((const f32x4*)xr)[lane + 64 * j]; }
#pragma unroll
        for (int q = 0; q < 4; ++q) { const int m = m0 + q; float s = 0.f;
#pragma unroll
            for (int j = 0; j < 4; ++j) s += (v[q][j].x * v[q][j].x + v[q][j].y * v[q][j].y) + (v[q][j].z * v[q][j].z + v[q][j].w * v[q][j].w);
            s = wave_sum(s);
            if (lane == 0) stat[m] = __builtin_amdgcn_rsqf(s * (1.0f / DM) + 1e-6f);
            u32x2* o = (u32x2*)(XB + (size_t)m * DM);
#pragma unroll
            for (int j = 0; j < 4; ++j) o[lane + 64 * j] = (u32x2){cvtpk(v[q][j].x, v[q][j].y), cvtpk(v[q][j].z, v[q][j].w)}; }
    }
    for (int m = gw; m < 240; m += NGW) { const int b = m / 30, i = m % 30;
        const f32x4 v0 = ((const f32x4*)(A.state_conv + (size_t)m * 512))[lane], v1 = ((const f32x4*)(A.state_conv + (size_t)m * 512))[lane + 64];
        u32x2* o = (u32x2*)((bf16_t*)(ws + WS_US) + ((size_t)b * 62 + i) * 512); o[lane] = (u32x2){cvtpk(v0.x, v0.y), cvtpk(v0.z, v0.w)}; o[lane + 64] = (u32x2){cvtpk(v1.x, v1.y), cvtpk(v1.z, v1.w)}; }
    bf16_t* KS = (bf16_t*)(ws + WS_KS);
    for (int m0 = gw * 4; m0 < 2 * 4096; m0 += NGW * 4) {
        f32x4 v0[4], v1[4];
#pragma unroll
        for (int q = 0; q < 4; ++q) { const int m = m0 + q, isv = m >= 4096, rr = m & 4095; const float* src = (isv ? A.cache_v : A.cache_k) + (size_t)rr * 512;
            v0[q] = ((const f32x4*)src)[lane]; v1[q] = ((const f32x4*)src)[lane + 64]; }
#pragma unroll
        for (int q = 0; q < 4; ++q) { const int m = m0 + q, isv = m >= 4096, rr = m & 4095, b = rr >> 9, pos = rr & 511;
            if (pos >= 32) { float* o = A.out + (isv ? OFF_VS : OFF_KS) + ((size_t)b * 512 + pos - 32) * 512; ((f32x4*)o)[lane] = v0[q]; ((f32x4*)o)[lane + 64] = v1[q]; }
            if (!isv) { u32x2* o = (u32x2*)(KS + ((size_t)b * 544 + pos) * 512); o[lane] = (u32x2){cvtpk(v0[q].x, v0[q].y), cvtpk(v0[q].z, v0[q].w)}; o[lane + 64] = (u32x2){cvtpk(v1[q].x, v1[q].y), cvtpk(v1[q].z, v1[q].w)}; } }
    }
}

template <int NQT>
__device__ __forceinline__ void attn_unit(const bf16_t* Qp, const bf16_t* Kb, const bf16_t* VTb, int vtp, int kt0, int kt1, const LAS float* bt, bf16_t* Op, int lane) {
    const int r = lane & 31, h = lane >> 5;
    const int krow = (r & ~12) | ((r & 4) << 1) | ((r & 8) >> 1);
    constexpr float SC = 0.125f * LOG2E;
    bf16x8 qf[NQT][4];
#pragma unroll
    for (int c = 0; c < NQT; ++c)
#pragma unroll
        for (int s = 0; s < 4; ++s) qf[c][s] = *(const bf16x8*)(Qp + (size_t)(32 * c + r) * 512 + 16 * s + 8 * h);
    f32x16 o[2][NQT]; float mrun[NQT], lrun[NQT];
#pragma unroll
    for (int c = 0; c < NQT; ++c) { mrun[c] = -1e30f; lrun[c] = 0.f;
#pragma unroll
        for (int dt = 0; dt < 2; ++dt)
#pragma unroll
            for (int i = 0; i < 16; ++i) o[dt][c][i] = 0.f; }
    const bf16_t* kp = Kb + (long)krow * 512 + 8 * h;
    const bf16_t* vp = VTb + (long)r * vtp + 8 * h;
    bf16x8 kf[4];
#pragma unroll
    for (int s = 0; s < 4; ++s) kf[s] = *(const bf16x8*)(kp + (long)kt0 * 32 * 512 + 16 * s);
    const float cbias = bt[256];
    bf16x8 vf[2][2];
#pragma unroll
    for (int dt = 0; dt < 2; ++dt)
#pragma unroll
        for (int s = 0; s < 2; ++s) vf[dt][s] = *(const bf16x8*)(vp + (long)(32 * dt) * vtp + 32 * kt0 + 16 * s);
    for (int kt = kt0; kt < kt1; ++kt) {
        const int ktn = (kt + 1 < kt1) ? kt + 1 : kt;
        bf16x8 kn[4], vn[2][2];
#pragma unroll
        for (int s = 0; s < 4; ++s) kn[s] = *(const bf16x8*)(kp + (long)ktn * 32 * 512 + 16 * s);
#pragma unroll
        for (int dt = 0; dt < 2; ++dt)
#pragma unroll
            for (int s = 0; s < 2; ++s) vn[dt][s] = *(const bf16x8*)(vp + (long)(32 * dt) * vtp + 32 * ktn + 16 * s);
        f32x16 sa[NQT];
#pragma unroll
        for (int c = 0; c < NQT; ++c) {
#pragma unroll
            for (int i = 0; i < 16; ++i) sa[c][i] = 0.f;
#pragma unroll
            for (int s = 0; s < 4; ++s) sa[c] = __builtin_amdgcn_mfma_f32_32x32x16_bf16(kf[s], qf[c][s], sa[c], 0, 0, 0); }
        bf16x8 pf[NQT][2];
#pragma unroll
        for (int c = 0; c < NQT; ++c) {
            if (kt <= 11) {
#pragma unroll
                for (int i = 0; i < 16; ++i) sa[c][i] = sa[c][i] * SC + cbias;
            } else {
                const int base = 32 * c + r - 32 * kt - 8 * h + 512;
#pragma unroll
                for (int i = 0; i < 16; ++i) { const int koff = (i & 3) + 4 * ((i >> 2) & 1) + 16 * (i >> 3); int rel = base - koff; rel = rel > 128 ? 128 : rel; sa[c][i] = sa[c][i] * SC + bt[rel + 128]; }
            }
            float mx = sa[c][0];
#pragma unroll
            for (int i = 1; i < 16; ++i) mx = fmaxf(mx, sa[c][i]);
            mx = fmaxf(mx, __shfl_xor(mx, 32));
            const float mnew = fmaxf(mrun[c], mx), alpha = __builtin_amdgcn_exp2f(mrun[c] - mnew);
            mrun[c] = mnew; float ls = 0.f;
#pragma unroll
            for (int i = 0; i < 16; ++i) { sa[c][i] = __builtin_amdgcn_exp2f(sa[c][i] - mnew); ls += sa[c][i]; }
            lrun[c] = lrun[c] * alpha + ls;
#pragma unroll
            for (int dt = 0; dt < 2; ++dt)
#pragma unroll
                for (int i = 0; i < 16; ++i) o[dt][c][i] *= alpha;
#pragma unroll
            for (int s = 0; s < 2; ++s) { u32x4 w; w.x = cvtpk(sa[c][8 * s + 0], sa[c][8 * s + 1]); w.y = cvtpk(sa[c][8 * s + 2], sa[c][8 * s + 3]); w.z = cvtpk(sa[c][8 * s + 4], sa[c][8 * s + 5]); w.w = cvtpk(sa[c][8 * s + 6], sa[c][8 * s + 7]);
                pf[c][s] = __builtin_bit_cast(bf16x8, w); }
        }
#pragma unroll
        for (int dt = 0; dt < 2; ++dt)
#pragma unroll
            for (int c = 0; c < NQT; ++c)
#pragma unroll
                for (int s = 0; s < 2; ++s) o[dt][c] = __builtin_amdgcn_mfma_f32_32x32x16_bf16(vf[dt][s], pf[c][s], o[dt][c], 0, 0, 0);
#pragma unroll
        for (int s = 0; s < 4; ++s) kf[s] = kn[s];
#pragma unroll
        for (int dt = 0; dt < 2; ++dt)
#pragma unroll
            for (int s = 0; s < 2; ++s) vf[dt][s] = vn[dt][s];
    }
#pragma unroll
    for (int c = 0; c < NQT; ++c) { const float l = lrun[c] + __shfl_xor(lrun[c], 32); const float inv = 1.0f / l;
#pragma unroll
        for (int dt = 0; dt < 2; ++dt)
#pragma unroll
            for (int g = 0; g < 4; ++g) { const int d = 32 * dt + 8 * g + 4 * h;
                *(u32x2*)(Op + (size_t)(32 * c + r) * 1024 + d) = (u32x2){cvtpk(o[dt][c][4 * g] * inv, o[dt][c][4 * g + 1] * inv), cvtpk(o[dt][c][4 * g + 2] * inv, o[dt][c][4 * g + 3] * inv)}; } }
}

__device__ __forceinline__ float bf_lo(unsigned w) { return __builtin_bit_cast(float, w << 16); }
__device__ __forceinline__ float bf_hi(unsigned w) { return __builtin_bit_cast(float, w & 0xffff0000u); }

__device__ __forceinline__ void conv_unit(const Args& A, const bf16_t* ub, int tmin, int t0, bf16_t* ob, LAS float* red, int tid, int lane, int wave) {
    const int tg = tid >> 8, cp = tid & 255, c = 2 * cp, tb = t0 + 8 * tg;
    unsigned uw[38];
#pragma unroll
    for (int i = 0; i < 38; ++i) { const int t = tb - 30 + i; const int tc = t < tmin ? tmin : t; uw[i] = *(const unsigned*)(ub + (long)tc * 512 + c); }
    f32x2 wv[31];
#pragma unroll
    for (int j = 0; j < 31; ++j) wv[j] = *(const f32x2*)(A.w_dw + (size_t)j * 512 + c);
    const f32x2 bd = *(const f32x2*)(A.b_dw + c);
    f32x2 in[38];
#pragma unroll
    for (int i = 0; i < 38; ++i) { const int t = tb - 30 + i; float a0 = bf_lo(uw[i]), a1 = bf_hi(uw[i]);
        if (i < 30) { a0 = t < tmin ? 0.f : a0; a1 = t < tmin ? 0.f : a1; }
        in[i] = (f32x2){a0, a1}; }
    f32x2 y[8];
#pragma unroll
    for (int k = 0; k < 8; ++k) y[k] = bd;
#pragma unroll
    for (int j = 0; j < 31; ++j) {
#pragma unroll
        for (int k = 0; k < 8; ++k) y[k] += wv[j] * in[k + j]; }
    float s1[8], s2[8];
#pragma unroll
    for (int k = 0; k < 8; ++k) { s1[k] = wave_sum(y[k].x + y[k].y); s2[k] = wave_sum(y[k].x * y[k].x + y[k].y * y[k].y); }
    if (lane == 0) {
#pragma unroll
        for (int k = 0; k < 8; ++k) { red[wave * 16 + k] = s1[k]; red[wave * 16 + 8 + k] = s2[k]; } }
    __syncthreads();
    const f32x2 lg = *(const f32x2*)(A.ln_g + c), lb = *(const f32x2*)(A.ln_b + c);
#pragma unroll
    for (int k = 0; k < 8; ++k) {
        float S1 = 0.f, S2 = 0.f;
#pragma unroll
        for (int w = 0; w < 4; ++w) { S1 += red[(4 * tg + w) * 16 + k]; S2 += red[(4 * tg + w) * 16 + 8 + k]; }
        const float mean = S1 * (1.0f / 512.0f), var = S2 * (1.0f / 512.0f) - mean * mean, rstd = __builtin_amdgcn_rsqf(var + 1e-5f);
        const float z0 = (y[k].x - mean) * rstd * lg.x + lb.x, z1 = (y[k].y - mean) * rstd * lg.y + lb.y;
        const float o0 = z0 * fast_sigmoid(z0), o1 = z1 * fast_sigmoid(z1);
        *(unsigned*)(ob + (size_t)(tb + k) * 1024 + c) = cvtpk(o0, o1);
    }
    __syncthreads();
}

template <bool BF>
__device__ __forceinline__ void sample_gemm(const bf16_t* As, const bf16_t* Wt, int K, const float* base, float* outf, bf16_t* outb, float* ss, LAS unsigned char* lds) {
    int tid_ = threadIdx.x; asm volatile("" : "+v"(tid_));
    const int lane = tid_ & 63, wave = __builtin_amdgcn_readfirstlane(tid_ >> 6), lr = lane & 15, lq = lane >> 4;
    LAS f32x4* red = (LAS f32x4*)lds;
    for (int tile = blockIdx.x; tile < 256; tile += gridDim.x) {
        const int r0 = (tile >> 4) * 16, c0 = (tile & 15) * 64;
        const int kw = K >> 3, kbeg = wave * kw, nks = kw >> 5;
        f32x4 acc[4];
#pragma unroll
        for (int ct = 0; ct < 4; ++ct) acc[ct] = (f32x4){0.f, 0.f, 0.f, 0.f};
        const bf16_t* ap = As + (size_t)(r0 + lr) * K + kbeg + 8 * lq;
        const bf16_t* bp = Wt + (size_t)(c0 + lr) * K + kbeg + 8 * lq;
#pragma unroll 4
        for (int ks = 0; ks < nks; ++ks) {
            const bf16x8 a = *(const bf16x8*)(ap + 32 * ks);
#pragma unroll
            for (int ct = 0; ct < 4; ++ct) { const bf16x8 b = *(const bf16x8*)(bp + (size_t)(16 * ct) * K + 32 * ks); acc[ct] = __builtin_amdgcn_mfma_f32_16x16x32_bf16(b, a, acc[ct], 0, 0, 0); }
        }
#pragma unroll
        for (int ct = 0; ct < 4; ++ct) red[(wave * 4 + ct) * 64 + lane] = acc[ct];
        __syncthreads();
        if (wave < 4) {
            f32x4 v = (f32x4){0.f, 0.f, 0.f, 0.f};
#pragma unroll
            for (int w = 0; w < 8; ++w) v += red[(w * 4 + wave) * 64 + lane];
            const int row = r0 + lr; const size_t off = (size_t)row * 1024 + c0 + 16 * wave + 4 * lq;
            v += *(const f32x4*)(base + off);
            *(f32x4*)(outf + off) = v;
            if (BF) *(u32x2*)(outb + off) = (u32x2){cvtpk(v[0], v[1]), cvtpk(v[2], v[3])};
            float s = (v[0] * v[0] + v[1] * v[1]) + (v[2] * v[2] + v[3] * v[3]);
            s += __shfl_xor(s, 16); s += __shfl_xor(s, 32);
            if (lq == 0) (void)__hip_atomic_fetch_add(ss + row, s, __ATOMIC_RELAXED, __HIP_MEMORY_SCOPE_AGENT);
        }
        __syncthreads();
    }
}

#define XB_TMO      128
#define XB_XCNT(j)  (256  + 64 * (j))
#define XB_XSUB(j)  (1280 + 64 * (j))
#define XB_XGEN(j)  (2304 + 64 * (j))
#define XB_TOP      3328
#define XB_TOPGEN   3392
#define XCD_BAR_WORDS 3456
#define XB_SPIN_CAP (1u << 18)

__device__ __forceinline__ unsigned xb_ld(unsigned* p)              { return __hip_atomic_load(p, __ATOMIC_RELAXED, __HIP_MEMORY_SCOPE_AGENT); }
__device__ __forceinline__ unsigned xb_add(unsigned* p, unsigned v) { return __hip_atomic_fetch_add(p, v, __ATOMIC_RELAXED, __HIP_MEMORY_SCOPE_AGENT); }
__device__ __forceinline__ unsigned xb_xcc_id() { return (unsigned)__builtin_amdgcn_s_getreg((3 << 11) | 20) & 0xFu; }
#define XB_SPIN(cond, bar) do { unsigned _sp = 0; while (cond) { __builtin_amdgcn_s_sleep(1); \
    if ((++_sp & 255u) == 0u) { if (xb_ld(&(bar)[XB_TMO])) break; if (_sp > XB_SPIN_CAP) { atomicAdd(&(bar)[XB_TMO], 1u); break; } } } } while (0)

struct XcdBarrier {
    unsigned* bar; unsigned x;
    volatile LAS unsigned* st;
};

__device__ __forceinline__ XcdBarrier xcd_barrier_post(unsigned* bar, volatile LAS unsigned* st) {
    XcdBarrier b; b.bar = bar; b.x = xb_xcc_id(); b.st = st;
    if (threadIdx.x == 0) (void)xb_add(&bar[XB_XCNT(b.x)], 1u);
    return b;
}
__device__ __forceinline__ void xcd_barrier_complete(unsigned* bar, unsigned x, unsigned& nloc, unsigned& nx) {
    const unsigned G = gridDim.x * gridDim.y * gridDim.z;
    unsigned sum, cnt, mine, sp = 0u;
    for (;;) {
        sum = 0u; cnt = 0u; mine = 0u;
#pragma unroll
        for (unsigned j = 0; j < 16; ++j) { const unsigned c = xb_ld(&bar[XB_XCNT(j)]); sum += c; cnt += (c > 0u) ? 1u : 0u; mine = (j == x) ? c : mine; }
        if (sum == G) break;
        __builtin_amdgcn_s_sleep(1);
        if ((++sp & 255u) == 0u) { if (xb_ld(&bar[XB_TMO])) break; if (sp > XB_SPIN_CAP) { atomicAdd(&bar[XB_TMO], 1u); break; } }
    }
    nloc = mine > 0u ? mine : 1u; nx = cnt > 0u ? cnt : 1u;
}

__device__ __forceinline__ void xcd_barrier(const XcdBarrier& b) {
    asm volatile("s_waitcnt vmcnt(0)" ::: "memory");
    __syncthreads();
    if (threadIdx.x == 0) {
        unsigned* bar = b.bar;
        __builtin_amdgcn_s_waitcnt(0);
        unsigned nloc = b.st[0], nx = b.st[1];
        if (nloc == 0u) { xcd_barrier_complete(bar, b.x, nloc, nx); b.st[0] = nloc; b.st[1] = nx; }
        const unsigned old = xb_add(&bar[XB_XSUB(b.x)], 1u);
        const unsigned gen = old / nloc;
        if (old + 1u == (gen + 1u) * nloc) {
            __builtin_amdgcn_fence(__ATOMIC_RELEASE, "agent");
            asm volatile("s_waitcnt vmcnt(0)" ::: "memory");
            const unsigned og = xb_add(&bar[XB_TOP], 1u);
            const unsigned tg = og / nx;
            if (og + 1u == (tg + 1u) * nx) xb_add(&bar[XB_TOPGEN], 1u);
            else XB_SPIN(xb_ld(&bar[XB_TOPGEN]) == tg, bar);
            __builtin_amdgcn_fence(__ATOMIC_ACQUIRE, "agent");
            xb_add(&bar[XB_XGEN(b.x)], 1u);
            asm volatile("s_waitcnt vmcnt(0)" ::: "memory");
        } else {
            XB_SPIN(xb_ld(&bar[XB_XGEN(b.x)]) == gen, bar);
            __builtin_amdgcn_fence(__ATOMIC_ACQUIRE, "agent");
            asm volatile("s_waitcnt vmcnt(0)" ::: "memory");
        }
    }
    __syncthreads();
}

#ifndef REP_P0
#define REP_P0 1
#endif
#ifndef REP_ATT
#define REP_ATT 1
#endif
#ifndef REP_CONV
#define REP_CONV 1
#endif
#ifndef REP_P1
#define REP_P1 1
#endif
#ifndef REP_P2
#define REP_P2 1
#endif
#ifndef REP_P4
#define REP_P4 1
#endif
__global__ void __launch_bounds__(NTHREADS, 2) fwd_megakernel(Args A) {
    extern __shared__ __attribute__((aligned(16))) unsigned char lds_raw[];
    cg::grid_group grid = cg::this_grid();
    LAS unsigned char* lds = (LAS unsigned char*)lds_raw;
#define FRESH_TID() int tid_ = threadIdx.x; asm volatile("" : "+v"(tid_)); const int tid = tid_, lane = tid & 63, wave = __builtin_amdgcn_readfirstlane(tid >> 6); (void)lane; (void)wave;
    const int G = gridDim.x;
    unsigned char* ws = A.ws;
    volatile LAS unsigned* xst = (volatile LAS unsigned*)(lds + 131072);
    if (threadIdx.x < 4) xst[threadIdx.x] = 0u;
    __syncthreads();
    (void)xcd_barrier_post((unsigned*)(ws + WS_BAR), xst);
#define GRID_SYNC() do { { XcdBarrier xb_; xb_.bar = (unsigned*)(A.ws + WS_BAR); xb_.x = xb_xcc_id(); xb_.st = (volatile LAS unsigned*)(lds + 131072); xcd_barrier(xb_); } } while (0)
    float* stat = (float*)(ws + WS_STAT);
    bf16_t* XB = (bf16_t*)(ws + WS_XB);

    for (int rep = 0; rep < REP_P0; ++rep) { FRESH_TID(); p0_prologue(A, lds, tid, lane, wave); }
    if (A.use_cg) grid.sync();
    GRID_SYNC();

    for (int rep = 0; rep < REP_P1; ++rep) {
        pg8::Gemm g{XB, (const bf16_t*)(ws + WS_WQKV), MROWS, DIN, DM}; pg8::StaticOrder S; S.init(MROWS, DIN, G, (int)blockIdx.x);
        pg8::EpiQKV E{stat, (bf16_t*)(ws + WS_Q), (bf16_t*)(ws + WS_KP), (bf16_t*)(ws + WS_KS), (bf16_t*)(ws + WS_VT), (bf16_t*)(ws + WS_VTS), (bf16_t*)(ws + WS_U), (bf16_t*)(ws + WS_US), A.out};
        pg8::gemm_phase<pg8::EpiQKV, pg8::StaticOrder, true, true>(lds, g, S, E);
    }
    GRID_SYNC();

    for (int rep = 0; rep < REP_P2; ++rep) {
        FRESH_TID();
        LAS float* bt = (LAS float*)lds; LAS float* red = (LAS float*)(lds + 16384);
        for (int i = tid; i < 8 * 257; i += NTHREADS) bt[i] = A.rel_table[i] * LOG2E;
        __syncthreads();
        const bf16_t* Q = (const bf16_t*)(ws + WS_Q); const bf16_t* KP = (const bf16_t*)(ws + WS_KP); const bf16_t* KS = (const bf16_t*)(ws + WS_KS);
        const bf16_t* VT = (const bf16_t*)(ws + WS_VT); const bf16_t* VTS = (const bf16_t*)(ws + WS_VTS); bf16_t* OC = (bf16_t*)(ws + WS_OC);
        for (int rep2 = 0; rep2 < REP_ATT; ++rep2)
        for (int pc = blockIdx.x; pc < 256; pc += G) {
            const int b = pc >> 5, c = pc & 31, hd = wave;
            const long row0 = (long)b * TS + 64 * c;
            attn_unit<2>(Q + row0 * 512 + hd * 64, KP + (row0 - 512) * 512 + hd * 64, VT + ((long)b * 512 + hd * 64) * TS + 64 * c - 512, TS, (16 - 2 * c) > 0 ? (16 - 2 * c) : 0, 18,
                         bt + hd * 257, OC + row0 * 1024 + hd * 64, lane);
            if (c == 0) { const long rs = RP + b * 32; int lane2 = threadIdx.x & 63; asm volatile("" : "+v"(lane2)); const int lane = lane2;
                attn_unit<1>(Q + rs * 512 + hd * 64, KS + (long)b * 544 * 512 + hd * 64, VTS + ((long)b * 512 + hd * 64) * 544, 544, 0, 17, bt + hd * 257, OC + rs * 1024 + hd * 64, lane); }
        }
        __syncthreads();
        int tid2 = threadIdx.x; asm volatile("" : "+v"(tid2));
        for (int rep2 = 0; rep2 < REP_CONV; ++rep2)
        for (int u = blockIdx.x; u < 1040; u += G) {
            const int tid = tid2, lane = tid2 & 63;
            const bool smp = u >= 1024; const int b = smp ? (u - 1024) >> 1 : u >> 7, t0 = smp ? ((u - 1024) & 1) * 16 : (u & 127) * 16;
            const bf16_t* ub = smp ? (const bf16_t*)(ws + WS_US) + ((size_t)b * 62 + 30) * 512 : (const bf16_t*)(ws + WS_U) + (size_t)b * TS * 512;
            conv_unit(A, ub, smp ? -30 : 0, t0, OC + (size_t)(smp ? RP + b * 32 : b * TS) * 1024 + 512, red, tid, lane, wave);
        }
    }
    GRID_SYNC();

    {
        pg8::Gemm g{(const bf16_t*)(ws + WS_OC), (const bf16_t*)(ws + WS_WO), RP, DM, DM}; pg8::StaticOrder S; S.init(RP, DM, G, (int)blockIdx.x);
        pg8::EpiRes<true> E{A.x_prompt, A.x_sample, A.out, XB, stat + MROWS};
        pg8::gemm_phase<pg8::EpiRes<true>, pg8::StaticOrder, true, true>(lds, g, S, E);
        sample_gemm<true>((const bf16_t*)(ws + WS_OC) + (size_t)RP * DM, (const bf16_t*)(ws + WS_WO), DM, A.x_sample, A.out + (size_t)RP * DM, XB + (size_t)RP * DM, stat + MROWS + RP, lds);
    }
    GRID_SYNC();

    for (int rep = 0; rep < REP_P4; ++rep) {
        pg8::Gemm g{XB, (const bf16_t*)(ws + WS_WGU), MROWS, NGU, DM}; pg8::StaticOrder S; S.init(MROWS, NGU, G, (int)blockIdx.x);
        pg8::EpiGU E{stat + MROWS, (bf16_t*)(ws + WS_HM)};
        pg8::gemm_phase<pg8::EpiGU, pg8::StaticOrder, true, true>(lds, g, S, E);
    }
    GRID_SYNC();

    {
        pg8::Gemm g{(const bf16_t*)(ws + WS_HM), (const bf16_t*)(ws + WS_WD), RP, DM, DFF}; pg8::StaticOrder S; S.init(RP, DM, G, (int)blockIdx.x);
        pg8::EpiRes<false> E{A.out, A.out + (size_t)RP * DM, A.out, nullptr, stat + 2 * MROWS};
        pg8::gemm_phase<pg8::EpiRes<false>, pg8::StaticOrder, true, true>(lds, g, S, E);
        sample_gemm<false>((const bf16_t*)(ws + WS_HM) + (size_t)RP * DFF, (const bf16_t*)(ws + WS_WD), DFF, A.out + (size_t)RP * DM, A.out + (size_t)RP * DM, nullptr, stat + 2 * MROWS + RP, lds);
    }
    GRID_SYNC();

    {
        FRESH_TID();
        const int gw = blockIdx.x * NWAVES + wave, NGW = G * NWAVES;
        f32x4 gf[4];
#pragma unroll
        for (int j = 0; j < 4; ++j) gf[j] = ((const f32x4*)A.g_final)[lane + 64 * j];
        for (int m = gw; m < MROWS; m += NGW) {
            f32x4* row = (f32x4*)(A.out + (size_t)m * DM);
            const float rs = __builtin_amdgcn_rsqf(stat[2 * MROWS + m] * (1.0f / DM) + 1e-6f);
#pragma unroll
            for (int j = 0; j < 4; ++j) row[lane + 64 * j] = row[lane + 64 * j] * rs * gf[j];
        }
    }
}

extern "C" void kernel_launch(void* const* d_in, const int* in_sizes, int n_in, void* d_out, int out_size, void* d_ws, size_t ws_size, hipStream_t stream) {
    static int grid = 0;
    if (grid == 0) {
        int dev = 0, cus = 0, per_cu = 0;
        hipGetDevice(&dev);
        hipDeviceGetAttribute(&cus, hipDeviceAttributeMultiprocessorCount, dev);
        if (hipFuncSetAttribute((const void*)fwd_megakernel, hipFuncAttributeMaxDynamicSharedMemorySize, LDS_BYTES) != hipSuccess) { fprintf(stderr, "hipFuncSetAttribute failed\n"); }
        hipOccupancyMaxActiveBlocksPerMultiprocessor(&per_cu, (const void*)fwd_megakernel, NTHREADS, LDS_BYTES);
        (void)hipGetLastError();
        if (per_cu < 1) per_cu = 1;
        grid = cus * per_cu;
    }
    Args a{};
    a.x_prompt = (const float*)d_in[0]; a.x_sample = (const float*)d_in[1]; a.cache_k = (const float*)d_in[2]; a.cache_v = (const float*)d_in[3]; a.state_conv = (const float*)d_in[4];
    a.g_mix = (const float*)d_in[5]; a.w_in = (const float*)d_in[6]; a.rel_table = (const float*)d_in[7]; a.w_dw = (const float*)d_in[8]; a.b_dw = (const float*)d_in[9];
    a.ln_g = (const float*)d_in[10]; a.ln_b = (const float*)d_in[11]; a.w_out = (const float*)d_in[12]; a.g_ffn = (const float*)d_in[13]; a.w_gate = (const float*)d_in[14];
    a.w_up = (const float*)d_in[15]; a.w_down = (const float*)d_in[16]; a.g_final = (const float*)d_in[17];
    a.out = (float*)d_out; a.ws = (unsigned char*)d_ws;
    a.use_cg = 0; a.pad = 0;
    (void)hipMemsetAsync((unsigned char*)d_ws + WS_BAR, 0, XCD_BAR_WORDS * 4, stream);
    void* args[] = {&a};
    hipError_t e = hipLaunchCooperativeKernel((const void*)fwd_megakernel, dim3(grid), dim3(NTHREADS), args, LDS_BYTES, stream);
    if (e != hipSuccess) fprintf(stderr, "cooperative launch failed: %s (grid %d)\n", hipGetErrorString(e), grid);
}
```
